# Optimizing an MI355X kernel written in HIP

```python
import jax, jax.numpy as jnp
from jax import lax
import numpy as np

D_MODEL = 2048
BATCH = 1
SEQ = 8192
DEPTH = 4

N_MIXERS = 3
N_HGRN_LAYERS = (DEPTH + N_MIXERS - 1) // N_MIXERS
DEEPNORM_ALPHA = (2 * DEPTH) ** 0.25
DEEPNORM_BETA = (8 * DEPTH) ** -0.25
LN_EPS = 1e-5
RMS_EPS = 1e-6
ROPE_THETA = 500000.0
ROPE_FRACTION = 4

HG_HEAD_DIM = 128
HG_HEADS = D_MODEL // HG_HEAD_DIM
HG_CHUNK = 64

NSA_HEAD_DIM = 128
NSA_HEADS = D_MODEL // NSA_HEAD_DIM
NSA_KV_GROUPS = 4
CMP_BLOCK = 32
CMP_STRIDE = 16
CMP_HIDDEN = 256
SLC_BLOCK = 64
SLC_TOPK = 16
NSA_WINDOW = 512
NSA_Q_BLOCK = 64
FORCE_BONUS = 1.0e4

SWA_HEAD_DIM = 64
SWA_HEADS = D_MODEL // SWA_HEAD_DIM
SWA_KV_HEADS = 4
SWA_WINDOW = 128

HG_IN = 4 * D_MODEL
NSA_IN = NSA_HEADS * NSA_HEAD_DIM + 6 * NSA_KV_GROUPS * NSA_HEAD_DIM + 3 * NSA_HEADS + D_MODEL
SWA_IN = SWA_HEADS * SWA_HEAD_DIM + 2 * SWA_KV_HEADS * SWA_HEAD_DIM + D_MODEL

kernel_name = "hybrid_hgrn2_nsa_swa_sink_deepnorm"

F32 = jnp.float32


def _layer_norm(x, g, b):
    xf = x.astype(F32)
    mu = jnp.mean(xf, -1, keepdims=True)
    xc = xf - mu
    var = jnp.mean(xc * xc, -1, keepdims=True)
    return (xc * lax.rsqrt(var + LN_EPS) * g.astype(F32) + b.astype(F32)).astype(x.dtype)


def _rotary_tables(positions, head_dim):
    rot = head_dim // ROPE_FRACTION
    inv_freq = ROPE_THETA ** (-jnp.arange(0, rot, 2, dtype=F32) / rot)
    ang = positions.astype(F32)[..., None] * inv_freq
    return jnp.cos(ang), jnp.sin(ang)


def _partial_rotary(t, cos, sin):
    half = cos.shape[-1]
    tf = t.astype(F32)
    c, s = cos[:, :, None, :], sin[:, :, None, :]
    x1, x2 = tf[..., :half], tf[..., half:2 * half]
    return jnp.concatenate([x1 * c - x2 * s, x2 * c + x1 * s, tf[..., 2 * half:]], -1).astype(t.dtype)


def _masked_softmax(scores, mask):
    s = jnp.where(mask, scores.astype(F32), -jnp.inf)
    m = jnp.max(s, -1, keepdims=True)
    m = jnp.where(jnp.isfinite(m), m, 0.0)
    e = jnp.exp(s - m)
    return e / jnp.maximum(jnp.sum(e, -1, keepdims=True), 1e-30)


def _hgrn_lower_bounds(lb_logits):
    lb = jnp.cumsum(jax.nn.softmax(lb_logits.astype(F32), axis=0), axis=0)
    return lb - lb[0:1]


def _hgrn2_mixer(x, w_in, g_norm, w_out, lower_bound):
    B, S, D = x.shape
    H, Dk, C = HG_HEADS, HG_HEAD_DIM, HG_CHUNK
    n_chunks = S // C
    q, f_logit, v, z = jnp.split(x @ w_in, 4, axis=-1)
    log_f = jnp.logaddexp(jnp.log(lower_bound),
                          jnp.log1p(-lower_bound) + jax.nn.log_sigmoid(f_logit.astype(F32)))
    k = -jnp.expm1(log_f)

    def chunks(t):
        return t.astype(F32).reshape(B, n_chunks, C, H, Dk).transpose(1, 0, 3, 2, 4)

    causal = jnp.tril(jnp.ones((C, C), dtype=bool))[:, :, None]

    def step(state, inp):
        q_c, k_c, v_c, g_c = inp
        b = jnp.cumsum(g_c, axis=2)
        o_inter = jnp.einsum('bhtk,bhkv->bhtv', q_c * jnp.exp(b), state)
        rel = jnp.where(causal, b[:, :, :, None, :] - b[:, :, None, :, :], -jnp.inf)
        a = jnp.einsum('bhtk,bhtsk->bhts', q_c, jnp.exp(rel) * k_c[:, :, None, :, :])
        o = o_inter + jnp.einsum('bhts,bhsv->bhtv', a, v_c)
        b_end = b[:, :, -1:, :]
        state = state * jnp.exp(b_end[:, :, 0, :, None]) + jnp.einsum(
            'bhsk,bhsv->bhkv', k_c * jnp.exp(b_end - b), v_c)
        return state, o

    state0 = jnp.zeros((B, H, Dk, Dk), F32)
    _, o = lax.scan(step, state0, (chunks(q), chunks(k), chunks(v), chunks(log_f)))
    o = o.transpose(1, 0, 3, 2, 4).reshape(B, S, H, Dk)
    o = o * lax.rsqrt(jnp.mean(o * o, -1, keepdims=True) + RMS_EPS)
    o = o.reshape(B, S, D) * g_norm.astype(F32) * jax.nn.silu(z.astype(F32))
    return o.astype(x.dtype) @ w_out


def _nsa_mixer(x, cos, sin, w_in, cmp_pos_k, cmp_w1_k, cmp_w2_k,
               cmp_pos_v, cmp_w1_v, cmp_w2_v, w_out):
    B, S, D = x.shape
    H, G, Dh = NSA_HEADS, NSA_KV_GROUPS, NSA_HEAD_DIM
    R = H // G
    QB = NSA_Q_BLOCK
    widths = [H * Dh] + [G * Dh] * 6 + [3 * H]
    q, k_c, v_c, k_s, v_s, k_w, v_w, gate_logit, z = jnp.split(
        x @ w_in, [int(c) for c in np.cumsum(widths)], axis=-1)
    q = _partial_rotary(q.reshape(B, S, H, Dh), cos, sin)
    k_c, k_s, k_w = (_partial_rotary(t.reshape(B, S, G, Dh), cos, sin) for t in (k_c, k_s, k_w))
    v_c, v_s, v_w = (t.reshape(B, S, G, Dh) for t in (v_c, v_s, v_w))

    n_cmp = S // CMP_STRIDE - 1

    def compress(t, pos, w1, w2):
        c = t.reshape(B, S // CMP_STRIDE, CMP_STRIDE, G, Dh)
        blk = jnp.concatenate([c[:, :-1], c[:, 1:]], axis=2) + pos[:, None, :]
        flat = blk.transpose(0, 1, 3, 2, 4).reshape(B, n_cmp, G, CMP_BLOCK * Dh)
        return jax.nn.silu(flat @ w1) @ w2

    kc_blk = compress(k_c, cmp_pos_k, cmp_w1_k, cmp_w2_k)
    vc_blk = compress(v_c, cmp_pos_v, cmp_w1_v, cmp_w2_v)
    cmp_end = jnp.arange(n_cmp) * CMP_STRIDE + CMP_BLOCK - 1

    n_slc = S // SLC_BLOCK
    top_k = min(SLC_TOPK, n_slc)
    ratio = SLC_BLOCK // CMP_STRIDE
    i_idx = np.arange(n_cmp)[:, None]
    j_idx = np.arange(n_slc)[None, :]
    agg = jnp.asarray((i_idx >= ratio * j_idx - CMP_BLOCK // CMP_STRIDE + 1)
                      & (i_idx <= ratio * j_idx + ratio - 1), F32)
    ks_blk = k_s.reshape(B, n_slc, SLC_BLOCK, G, Dh).transpose(0, 3, 1, 2, 4)
    vs_blk = v_s.reshape(B, n_slc, SLC_BLOCK, G, Dh).transpose(0, 3, 1, 2, 4)
    gather = jax.vmap(jax.vmap(lambda t, ix: t[ix]))

    kw_pad = jnp.pad(k_w, ((0, 0), (NSA_WINDOW, 0), (0, 0), (0, 0)))
    vw_pad = jnp.pad(v_w, ((0, 0), (NSA_WINDOW, 0), (0, 0), (0, 0)))
    scale = Dh ** -0.5
    n_qb = S // QB
    q_blocks = q.reshape(B, n_qb, QB, G, R, Dh).transpose(1, 0, 2, 3, 4, 5)
    g_blocks = jax.nn.sigmoid(gate_logit.astype(F32)).reshape(B, n_qb, QB, 3, H).transpose(1, 0, 2, 3, 4)
    j = jnp.arange(n_slc)
    w_off = jnp.arange(QB + NSA_WINDOW)

    def attend_block(args):
        blk, qb, gb = args
        start = blk * QB
        t_pos = start + jnp.arange(QB)
        s_c = jnp.einsum('bqgrd,bngd->bgrqn', qb, kc_blk) * scale
        p_c = _masked_softmax(s_c, cmp_end[None, :] <= t_pos[:, None])
        o_cmp = jnp.einsum('bgrqn,bngd->bqgrd', p_c, vc_blk)
        imp = jnp.einsum('bgrqn,nj->bgqj', p_c, agg)
        cur = t_pos[:, None] // SLC_BLOCK
        allowed = j[None, :] * SLC_BLOCK <= t_pos[:, None]
        forced = (j[None, :] == 0) | (j[None, :] == cur) | (j[None, :] == cur - 1)
        imp = jnp.where(allowed, imp + jnp.where(forced, FORCE_BONUS, 0.0), -jnp.inf)
        _, sel = lax.top_k(imp, top_k)
        k_sel = gather(ks_blk, sel)
        v_sel = gather(vs_blk, sel)
        kpos = sel[..., None] * SLC_BLOCK + jnp.arange(SLC_BLOCK)
        m_s = (kpos <= t_pos[:, None, None])[:, :, None]
        s_s = jnp.einsum('bqgrd,bgqkld->bgrqkl', qb, k_sel) * scale
        p_s = _masked_softmax(s_s.reshape(B, G, R, QB, -1), m_s.reshape(B, G, 1, QB, -1))
        o_slc = jnp.einsum('bgrqkl,bgqkld->bqgrd', p_s.reshape(s_s.shape), v_sel)
        kw = lax.dynamic_slice_in_dim(kw_pad, start, QB + NSA_WINDOW, axis=1)
        vw = lax.dynamic_slice_in_dim(vw_pad, start, QB + NSA_WINDOW, axis=1)
        wpos = start - NSA_WINDOW + w_off
        diff = t_pos[:, None] - wpos[None, :]
        m_w = (diff >= 0) & (diff < NSA_WINDOW) & (wpos[None, :] >= 0)
        s_w = jnp.einsum('bqgrd,bkgd->bgrqk', qb, kw) * scale
        o_win = jnp.einsum('bgrqk,bkgd->bqgrd', _masked_softmax(s_w, m_w), vw)
        gate = lambda i: gb[:, :, i].reshape(B, QB, G, R, 1)
        o = gate(0) * o_cmp + gate(1) * o_slc + gate(2) * o_win
        return o.reshape(B, QB, H * Dh)

    o = lax.map(attend_block, (jnp.arange(n_qb), q_blocks, g_blocks))
    o = o.transpose(1, 0, 2, 3).reshape(B, S, H * Dh)
    return (o * jax.nn.silu(z.astype(F32))).astype(x.dtype) @ w_out


def _swa_sink_mixer(x, cos, sin, w_in, sinks, w_out):
    B, S, D = x.shape
    H, KV, Dh, W = SWA_HEADS, SWA_KV_HEADS, SWA_HEAD_DIM, SWA_WINDOW
    R = H // KV
    n_blk = S // W
    q, k, v, z = jnp.split(x @ w_in, [H * Dh, H * Dh + KV * Dh, H * Dh + 2 * KV * Dh], axis=-1)
    q = _partial_rotary(q.reshape(B, S, H, Dh), cos, sin).reshape(B, n_blk, W, KV, R, Dh)
    k = _partial_rotary(k.reshape(B, S, KV, Dh), cos, sin).reshape(B, n_blk, W, KV, Dh)
    v = v.reshape(B, n_blk, W, KV, Dh)

    def with_prev(t):
        prev = jnp.concatenate([jnp.zeros_like(t[:, :1]), t[:, :-1]], axis=1)
        return jnp.concatenate([prev, t], axis=2)

    kk, vv = with_prev(k), with_prev(v)
    q_off = jnp.arange(W)[:, None]
    k_off = jnp.arange(2 * W)[None, :] - W
    diff = q_off - k_off
    band = (diff >= 0) & (diff < W)
    real = (jnp.arange(n_blk) > 0)[:, None, None] | (k_off >= 0)[None]
    mask = (band[None] & real)[None, :, None, None]
    s = jnp.einsum('bnqgrd,bnkgd->bngrqk', q, kk).astype(F32) * (Dh ** -0.5)
    s = jnp.where(mask, s, -jnp.inf)
    sink = jnp.broadcast_to(sinks.astype(F32).reshape(1, 1, KV, R, 1, 1), s.shape[:-1] + (1,))
    p = jax.nn.softmax(jnp.concatenate([s, sink], axis=-1), axis=-1)[..., :-1]
    o = jnp.einsum('bngrqk,bnkgd->bnqgrd', p, vv).reshape(B, S, H * Dh)
    return (o * jax.nn.silu(z.astype(F32))).astype(x.dtype) @ w_out


def setup_inputs(seed: int = 0) -> dict:
    key = jax.random.key(seed)
    ks = iter(jax.random.split(key, 48))
    D = D_MODEL

    def dense(fan_in, fan_out, scale=1.0):
        return jax.random.normal(next(ks), (fan_in, fan_out), F32) * (fan_in ** -0.5) * scale

    def gain(n):
        return 1.0 + 0.02 * jax.random.normal(next(ks), (n,), F32)

    def small(shape):
        return 0.02 * jax.random.normal(next(ks), shape, F32)

    x = jax.random.normal(next(ks), (BATCH, SEQ, D), F32)
    positions = (jax.random.randint(next(ks), (BATCH, 1), 0, 4096, dtype=jnp.int32)
                 + jnp.arange(SEQ, dtype=jnp.int32)[None, :])
    hgrn_lb_logits = 0.5 * jax.random.normal(next(ks), (N_HGRN_LAYERS, D), F32)
    cmp_in = CMP_BLOCK * NSA_HEAD_DIM
    return {
        "x": x,
        "positions": positions,
        "hgrn_lb_logits": hgrn_lb_logits,
        "l0_w_in": dense(D, HG_IN),
        "l0_g_norm": gain(D),
        "l0_w_out": dense(D, D, DEEPNORM_BETA),
        "l0_ln_g": gain(D),
        "l0_ln_b": small((D,)),
        "l1_w_in": dense(D, NSA_IN),
        "l1_cmp_pos_k": small((CMP_BLOCK, NSA_HEAD_DIM)),
        "l1_cmp_w1_k": dense(cmp_in, CMP_HIDDEN),
        "l1_cmp_w2_k": dense(CMP_HIDDEN, NSA_HEAD_DIM),
        "l1_cmp_pos_v": small((CMP_BLOCK, NSA_HEAD_DIM)),
        "l1_cmp_w1_v": dense(cmp_in, CMP_HIDDEN),
        "l1_cmp_w2_v": dense(CMP_HIDDEN, NSA_HEAD_DIM),
        "l1_w_out": dense(D, D, DEEPNORM_BETA),
        "l1_ln_g": gain(D),
        "l1_ln_b": small((D,)),
        "l2_w_in": dense(D, SWA_IN),
        "l2_sinks": 0.5 * jax.random.normal(next(ks), (SWA_HEADS,), F32),
        "l2_w_out": dense(D, D, DEEPNORM_BETA),
        "l2_ln_g": gain(D),
        "l2_ln_b": small((D,)),
        "l3_w_in": dense(D, HG_IN),
        "l3_g_norm": gain(D),
        "l3_w_out": dense(D, D, DEEPNORM_BETA),
        "l3_ln_g": gain(D),
        "l3_ln_b": small((D,)),
    }


def reference(x, positions, hgrn_lb_logits,
              l0_w_in, l0_g_norm, l0_w_out, l0_ln_g, l0_ln_b,
              l1_w_in, l1_cmp_pos_k, l1_cmp_w1_k, l1_cmp_w2_k,
              l1_cmp_pos_v, l1_cmp_w1_v, l1_cmp_w2_v, l1_w_out, l1_ln_g, l1_ln_b,
              l2_w_in, l2_sinks, l2_w_out, l2_ln_g, l2_ln_b,
              l3_w_in, l3_g_norm, l3_w_out, l3_ln_g, l3_ln_b):
    layer_params = (
        (l0_w_in, l0_g_norm, l0_w_out, l0_ln_g, l0_ln_b),
        (l1_w_in, l1_cmp_pos_k, l1_cmp_w1_k, l1_cmp_w2_k,
         l1_cmp_pos_v, l1_cmp_w1_v, l1_cmp_w2_v, l1_w_out, l1_ln_g, l1_ln_b),
        (l2_w_in, l2_sinks, l2_w_out, l2_ln_g, l2_ln_b),
        (l3_w_in, l3_g_norm, l3_w_out, l3_ln_g, l3_ln_b),
    )
    lower_bounds = _hgrn_lower_bounds(hgrn_lb_logits)
    cos_nsa, sin_nsa = _rotary_tables(positions, NSA_HEAD_DIM)
    cos_swa, sin_swa = _rotary_tables(positions, SWA_HEAD_DIM)
    h = x
    for i in range(DEPTH):
        p = layer_params[i]
        kind = i % N_MIXERS
        if kind == 0:
            y = _hgrn2_mixer(h, p[0], p[1], p[2], lower_bounds[i // N_MIXERS])
        elif kind == 1:
            y = _nsa_mixer(h, cos_nsa, sin_nsa, *p[:-2])
        else:
            y = _swa_sink_mixer(h, cos_swa, sin_swa, *p[:-2])
        h = _layer_norm(DEEPNORM_ALPHA * h + y, p[-2], p[-1])
    return h
```

```cpp
#include <hip/hip_runtime.h>
#include <cstdio>
#include <cstdint>
#include <cmath>
#define GAS __attribute__((address_space(1)))
#define LAS __attribute__((address_space(3)))
typedef unsigned short bf16;
typedef unsigned v4u __attribute__((ext_vector_type(4)));
typedef unsigned v2u __attribute__((ext_vector_type(2)));
typedef float f32x4 __attribute__((ext_vector_type(4)));
typedef float f32x16 __attribute__((ext_vector_type(16)));
typedef short bf16x8 __attribute__((ext_vector_type(8)));
typedef short s16x4 __attribute__((ext_vector_type(4)));
typedef GAS unsigned gu32;
#define RLX_AGENT __ATOMIC_RELAXED, __HIP_MEMORY_SCOPE_AGENT
#define LDS_WAIT() asm volatile("s_waitcnt lgkmcnt(0)" ::: "memory")
typedef float f32x2_t __attribute__((ext_vector_type(2)));
typedef __bf16 bf16x2_t __attribute__((ext_vector_type(2)));
typedef unsigned u32x2 __attribute__((ext_vector_type(2)));
__device__ __forceinline__ unsigned pkbf(float lo, float hi) { f32x2_t v = {lo, hi}; bf16x2_t b = __builtin_convertvector(v, bf16x2_t); return __builtin_bit_cast(unsigned, b); }
__device__ __forceinline__ u32x2 pk4(f32x4 v) { u32x2 r; r.x = pkbf(v[0], v[1]); r.y = pkbf(v[2], v[3]); return r; }
__device__ __forceinline__ float fsilu(float x) { return x / (1.f + __expf(-x)); }
__device__ __forceinline__ float fsigm(float x) { return 1.f / (1.f + __expf(-x)); }
__device__ __forceinline__ float bf2f(unsigned short x) { return __uint_as_float((unsigned)x << 16); }
__device__ __forceinline__ float bflo(unsigned x) { return __uint_as_float(x << 16); }
__device__ __forceinline__ float bfhi(unsigned x) { return __uint_as_float(x & 0xffff0000u); }
__device__ __forceinline__ f32x4 mfma16(bf16x8 a, bf16x8 b, f32x4 c) { return __builtin_amdgcn_mfma_f32_16x16x32_bf16(a, b, c, 0, 0, 0); }
__device__ __forceinline__ f32x16 mfma32(bf16x8 a, bf16x8 b, f32x16 c) { return __builtin_amdgcn_mfma_f32_32x32x16_bf16(a, b, c, 0, 0, 0); }
typedef short v4i16_t __attribute__((ext_vector_type(4)));
__device__ __forceinline__ s16x4 tr_rd(const LAS unsigned char* p) { return __builtin_bit_cast(s16x4, __builtin_amdgcn_ds_read_tr16_b64_v4i16((LAS v4i16_t*)p)); }
__device__ __forceinline__ bf16x8 ld_frag(const LAS unsigned char* p) { return *(const LAS bf16x8*)p; }
__device__ __forceinline__ int crow(int r, int hi) { return (r & 3) + 8 * (r >> 2) + 4 * hi; }
__device__ __forceinline__ float swap_max(float m) { auto rr = __builtin_amdgcn_permlane32_swap(__float_as_uint(m), __float_as_uint(m), false, false); return fmaxf(__uint_as_float(rr[0]), __uint_as_float(rr[1])); }
__device__ __forceinline__ float swap_sum(float m) { auto rr = __builtin_amdgcn_permlane32_swap(__float_as_uint(m), __float_as_uint(m), false, false); return __uint_as_float(rr[0]) + __uint_as_float(rr[1]); }
__device__ __forceinline__ float swap_other(float m, int hi) { auto rr = __builtin_amdgcn_permlane32_swap(__float_as_uint(m), __float_as_uint(m), false, false); return hi ? __uint_as_float(rr[0]) : __uint_as_float(rr[1]); }

constexpr int S = 8192, DM = 2048, NWAVES = 8;
constexpr float ALPHA = 1.681792830507429f, LN_EPS = 1e-5f, RMS_EPS = 1e-6f, LOG2E = 1.4426950408889634f;
constexpr float QS_NSA = 0.08838834764831845f * LOG2E, QS_SWA = 0.125f * LOG2E;
constexpr float NEG_INF = -INFINITY;

constexpr size_t MiB = 1u << 20;
constexpr size_t WS_CTL = 0, CTL_ZERO_BYTES = 1 * MiB;
constexpr size_t WS_COSN = 1 * MiB, WS_SINN = WS_COSN + 512 * 1024, WS_COSW = 2 * MiB, WS_SINW = WS_COSW + 256 * 1024, WS_LB = WS_COSW + 512 * 1024, WS_C1P = 3 * MiB;
constexpr size_t WS_WIN = 4 * MiB, WS_W1TK = WS_WIN + 29 * MiB, WS_W1TV = WS_WIN + 31 * MiB, WS_W2TK = WS_WIN + 33 * MiB, WS_W2TV = WS_W2TK + 65536;
constexpr size_t WS_WOUT = 38 * MiB, WS_HB = 46 * MiB, WS_QB = 78 * MiB;
constexpr size_t WS_GB = 110 * MiB, WS_VB = 174 * MiB, WS_ZS = 206 * MiB, WS_AM = 238 * MiB, WS_UT = 254 * MiB, WS_ACC = 254 * MiB  , WS_DD = 318 * MiB, WS_END = 319 * MiB;
constexpr size_t WS_KV = 110 * MiB, KV_SLOT = 9 * MiB  , WS_GATE = 164 * MiB, WS_CB = 166 * MiB;
constexpr size_t WS_KS = 110 * MiB, WS_VS = 114 * MiB;
constexpr int CW_BAR = 4096;

constexpr int RING_BYTES = 131072, LDSCTL_OFF = RING_BYTES, MISC_OFF = LDSCTL_OFF + 320, LDS_BYTES = 147456;
namespace pg8 {
#define PG8_LAS __attribute__((address_space(3)))
typedef unsigned short bf16_t;
typedef short bf16x8 __attribute__((ext_vector_type(8)));
typedef float f32x4 __attribute__((ext_vector_type(4)));
typedef unsigned u32x4 __attribute__((ext_vector_type(4)));
constexpr int BM = 256, BK = 64, HALF = 128, HTB = HALF * BK * 2  , STAGE_BYTES = 8 * HTB, NXCD = 8, WGM = 8;

__host__ __device__ __forceinline__ int lds_byte(int r, int c) { const int st = (r >> 4) * 2 + (c >> 5), rr = r & 15, cc = c & 31, ob = rr * 64 + cc * 2; return st * 1024 + (ob ^ (((ob >> 9) & 1) << 5)); }
__host__ __device__ __forceinline__ void stage_rc(int b, int& R, int& C) { const int st = b / 1024, sb = b % 1024, swz = sb ^ (((sb >> 9) & 1) << 5); R = (st >> 1) * 16 + swz / 64; C = (st & 1) * 32 + (swz % 64) / 2; }
__host__ __device__ __forceinline__ int perm32(int rho) { const int n = rho >> 4, i = rho & 15; return 8 * (i >> 2) + 4 * n + (i & 3); }

struct Unit { int pm, pn; };
struct Gemm { const bf16_t* A; const bf16_t* Bt; int M, N, K; };

struct StaticOrder {
    int nM, nN, nwg, G, c;
    __host__ __device__ void init(int M, int N, int G_, int c_) { nM = M / BM; nN = N / BM; nwg = nM * nN; G = G_; c = c_; }
    __host__ __device__ bool next(int i, Unit& u) const {
        const long L = (long)i * G + c; if (L >= nwg) return false;
        int wgid = (int)L; { const int q = nwg / NXCD, r = nwg % NXCD, xcd = wgid % NXCD, off = wgid / NXCD; wgid = (xcd < r ? xcd * (q + 1) : r * (q + 1) + (xcd - r) * q) + off; }
        const int nig = WGM * nN, gid = wgid / nig, fm = gid * WGM, gsz = (nM - fm) < WGM ? (nM - fm) : WGM;
        u.pm = fm + ((wgid % nig) % gsz); u.pn = (wgid % nig) / gsz; return true;
    }
    __device__ __forceinline__ void a_ready(const Unit&) const {}
    __device__ __forceinline__ void done(const Unit&) const {}
};

constexpr int SEQ = 8192, DMODEL = 2048;
#define EPI_FENCE() asm volatile("" ::: "memory")
struct EpiHG {
    static constexpr bool PERM = false, AFTER_DRAIN = false;
    unsigned char* ws; const float* lb;
    __device__ __forceinline__ void operator()(const f32x4 (&acc)[2][2][4][2], const Unit& u, int wr, int wc, int fr, int fq) const {
        const int region = u.pn >> 3, cb = (u.pn & 7) * 256 + wc * 32 + 4 * fq, row0 = u.pm * BM + wr * 64 + fr;
        bf16_t* Q = (bf16_t*)(ws + WS_QB); float* G = (float*)(ws + WS_GB); bf16_t* V = (bf16_t*)(ws + WS_VB); bf16_t* Z = (bf16_t*)(ws + WS_ZS);
#pragma unroll
        for (int ai = 0; ai < 2; ++ai)
#pragma unroll
            for (int m = 0; m < 4; ++m) { const size_t ro = (size_t)(row0 + ai * HALF + m * 16) * DMODEL;
#pragma unroll
                for (int bj = 0; bj < 2; ++bj)
#pragma unroll
                    for (int n = 0; n < 2; ++n) { const int c = cb + bj * HALF + n * 16; const f32x4 v = acc[ai][bj][m][n];
                        if (region == 0) *(u32x2*)(Q + ro + c) = pk4(v);
                        else if (region == 2) *(u32x2*)(V + ro + c) = pk4(v);
                        else if (region == 3) { f32x4 z; z[0] = fsilu(v[0]); z[1] = fsilu(v[1]); z[2] = fsilu(v[2]); z[3] = fsilu(v[3]); *(u32x2*)(Z + ro + c) = pk4(z); }
                        else { f32x4 g;
                            if (lb) { const f32x4 l = *(const f32x4*)(lb + c);
#pragma unroll
                                for (int e = 0; e < 4; ++e) g[e] = __logf(l[e] + (1.f - l[e]) * fsigm(v[e])); }
                            else {
#pragma unroll
                                for (int e = 0; e < 4; ++e) g[e] = fminf(v[e], 0.f) - __logf(1.f + __expf(-fabsf(v[e]))); }
                            *(f32x4*)(G + ro + c) = g; } }
                EPI_FENCE(); }
    }
};
struct EpiNSA {
    static constexpr bool PERM = false, AFTER_DRAIN = false;
    unsigned char* ws;
    __device__ __forceinline__ void operator()(const f32x4 (&acc)[2][2][4][2], const Unit& u, int wr, int wc, int fr, int fq) const {
        const int pn = u.pn, row0 = u.pm * BM + wr * 64 + fr;
        bf16_t* Q = (bf16_t*)(ws + WS_QB); bf16_t* KV = (bf16_t*)(ws + WS_KV); bf16_t* Z = (bf16_t*)(ws + WS_ZS); float* GATE = (float*)(ws + WS_GATE);
        const float* cosT = (const float*)(ws + WS_COSN); const float* sinT = (const float*)(ws + WS_SINN);
#pragma unroll
        for (int ai = 0; ai < 2; ++ai)
#pragma unroll
            for (int m = 0; m < 4; ++m) { const int r = row0 + ai * HALF + m * 16;
#pragma unroll
                for (int bj = 0; bj < 2; ++bj) {
                    f32x4 v0 = acc[ai][bj][m][0], v1 = acc[ai][bj][m][1];
                    if (pn < 20) {
                        int slot = 0, g = 0; const bool isq = pn < 8;
                        if (!isq) { slot = (pn - 8) >> 1; g = ((pn - 8) & 1) * 2 + bj; }
                        if ((isq || !(slot & 1)) && wc == 0) {
                            const f32x4 cs = *(const f32x4*)(cosT + (size_t)r * 16 + 4 * fq), sn = *(const f32x4*)(sinT + (size_t)r * 16 + 4 * fq);
                            const f32x4 a = v0 * cs - v1 * sn, b = v1 * cs + v0 * sn; v0 = a; v1 = b; }
                        const int d = wc * 32 + 4 * fq;
                        if (isq) { bf16_t* p = Q + (size_t)r * DMODEL + pn * 256 + bj * HALF + d; *(u32x2*)p = pk4(v0 * QS_NSA); *(u32x2*)(p + 16) = pk4(v1 * QS_NSA); }
                        else { bf16_t* p = KV + (size_t)slot * (KV_SLOT / 2) + ((size_t)g * SEQ + r) * 128 + d; *(u32x2*)p = pk4(v0); *(u32x2*)(p + 16) = pk4(v1); }
                    } else if (pn < 28) {
                        bf16_t* p = Z + (size_t)r * DMODEL + (pn - 20) * 256 + bj * HALF + wc * 32 + 4 * fq;
                        f32x4 z0, z1;
#pragma unroll
                        for (int e = 0; e < 4; ++e) { z0[e] = fsilu(v0[e]); z1[e] = fsilu(v1[e]); }
                        *(u32x2*)p = pk4(z0); *(u32x2*)(p + 16) = pk4(z1);
                    } else if (bj == 0 && wc < 2) {
                        float* p = GATE + (size_t)r * 48 + wc * 32 + 4 * fq;
                        f32x4 s0, s1;
#pragma unroll
                        for (int e = 0; e < 4; ++e) { s0[e] = fsigm(v0[e]); s1[e] = fsigm(v1[e]); }
                        *(f32x4*)p = s0; if (wc == 0) *(f32x4*)(p + 16) = s1;
                    } }
                EPI_FENCE(); }
    }
};
struct EpiSWA {
    static constexpr bool PERM = false, AFTER_DRAIN = false;
    unsigned char* ws;
    __device__ __forceinline__ void operator()(const f32x4 (&acc)[2][2][4][2], const Unit& u, int wr, int wc, int fr, int fq) const {
        const int pn = u.pn, row0 = u.pm * BM + wr * 64 + fr;
        bf16_t* Q = (bf16_t*)(ws + WS_QB); bf16_t* KS = (bf16_t*)(ws + WS_KS); bf16_t* VS = (bf16_t*)(ws + WS_VS); bf16_t* Z = (bf16_t*)(ws + WS_ZS);
        const float* cosT = (const float*)(ws + WS_COSW); const float* sinT = (const float*)(ws + WS_SINW);
#pragma unroll
        for (int ai = 0; ai < 2; ++ai)
#pragma unroll
            for (int m = 0; m < 4; ++m) { const int r = row0 + ai * HALF + m * 16;
#pragma unroll
                for (int bj = 0; bj < 2; ++bj) {
                    f32x4 v0 = acc[ai][bj][m][0], v1 = acc[ai][bj][m][1];
                    if (pn < 9) {
                        if ((wc & 1) == 0) {
                            f32x4 xp;
#pragma unroll
                            for (int e = 0; e < 4; ++e) xp[e] = __shfl_xor(v0[e], 32);
                            const f32x4 cs = *(const f32x4*)(cosT + (size_t)r * 8 + 4 * (fq & 1)), sn = *(const f32x4*)(sinT + (size_t)r * 8 + 4 * (fq & 1));
                            v0 = (fq < 2) ? (v0 * cs - xp * sn) : (v0 * cs + xp * sn); }
                        if (pn < 8) { bf16_t* p = Q + (size_t)r * DMODEL + pn * 256 + bj * HALF + wc * 32 + 4 * fq; *(u32x2*)p = pk4(v0 * QS_SWA); *(u32x2*)(p + 16) = pk4(v1 * QS_SWA); }
                        else { const int kvh = bj * 2 + (wc >> 1), d = (wc & 1) * 32 + 4 * fq; bf16_t* p = KS + ((size_t)kvh * SEQ + r) * 64 + d; *(u32x2*)p = pk4(v0); *(u32x2*)(p + 16) = pk4(v1); }
                    } else if (pn == 9) {
                        const int kvh = bj * 2 + (wc >> 1), d = (wc & 1) * 32 + 4 * fq; bf16_t* p = VS + ((size_t)kvh * SEQ + r) * 64 + d; *(u32x2*)p = pk4(v0); *(u32x2*)(p + 16) = pk4(v1);
                    } else {
                        bf16_t* p = Z + (size_t)r * DMODEL + (pn - 10) * 256 + bj * HALF + wc * 32 + 4 * fq;
                        f32x4 z0, z1;
#pragma unroll
                        for (int e = 0; e < 4; ++e) { z0[e] = fsilu(v0[e]); z1[e] = fsilu(v1[e]); }
                        *(u32x2*)p = pk4(z0); *(u32x2*)(p + 16) = pk4(z1);
                    } }
                EPI_FENCE(); }
    }
};
struct EpiOut {
    static constexpr bool PERM = false, AFTER_DRAIN = false;
    const float* hprev; float* U;
    __device__ __forceinline__ void operator()(const f32x4 (&acc)[2][2][4][2], const Unit& u, int wr, int wc, int fr, int fq) const {
        const int row0 = u.pm * BM + wr * 64 + fr, cb = u.pn * BM + wc * 32 + 4 * fq;
#pragma unroll
        for (int ai = 0; ai < 2; ++ai)
#pragma unroll
            for (int m = 0; m < 4; ++m) { const size_t ro = (size_t)(row0 + ai * HALF + m * 16) * DMODEL;
#pragma unroll
                for (int bj = 0; bj < 2; ++bj)
#pragma unroll
                    for (int n = 0; n < 2; ++n) { const size_t o = ro + cb + bj * HALF + n * 16; const f32x4 hv = *(const f32x4*)(hprev + o); *(f32x4*)(U + o) = hv * ALPHA + acc[ai][bj][m][n]; }
                if (m & 1) EPI_FENCE(); }
    }
};
template <class Epi, class Sched, bool ALIGN_EPI = false, bool SP2 = false>
__device__ __forceinline__ void gemm_phase(PG8_LAS unsigned char* lds, const Gemm g, const Sched& S, const Epi& E) {
    int tid_ = threadIdx.x; asm volatile("" : "+v"(tid_));
    const int tid = tid_, wid = __builtin_amdgcn_readfirstlane(tid >> 6), lane = tid & 63, wr = wid >> 2, wc = wid & 3, fr = lane & 15, fq = lane >> 4;
    const int K = g.K, nt = K / BK;
    unsigned voffA[2], voffB[2];
#pragma unroll
    for (int i = 0; i < 2; ++i) { int R, C; stage_rc(tid * 16 + i * 8192, R, C); const int Rb = Epi::PERM ? ((R & ~31) + perm32(R & 31)) : R;
        voffA[i] = (unsigned)(R * K + C) * 2u; voffB[i] = (unsigned)(Rb * K + C) * 2u; }
    const size_t kstep = (size_t)(BK * 2);
    const size_t hstep = (size_t)HALF * K * 2;
    const size_t tstep = 2 * hstep;
    const unsigned ldsw = (unsigned)wid * 1024u;
    const int aoff = lds_byte(wr * 64 + fr, fq * 8), boff = lds_byte(wc * 32 + fr, fq * 8);
#define PG8_SA(b, h) (((b) * 2 + (h)) * HTB)
#define PG8_SB(b, h) ((4 + (b) * 2 + (h)) * HTB)
#define PG8_STAGE(bufoff, gbase, voff) do { _Pragma("unroll") for (int _i = 0; _i < 2; ++_i) \
        __builtin_amdgcn_global_load_lds((const unsigned*)((const char*)(gbase) + (voff)[_i]), (PG8_LAS unsigned*)(lds + (bufoff) + ldsw + _i * 8192), 16, 0, 0); } while (0)
#define PG8_LDA(dst, b, h) do { _Pragma("unroll") for (int m = 0; m < 4; ++m) _Pragma("unroll") for (int k = 0; k < 2; ++k) dst[m][k] = *(const PG8_LAS bf16x8*)(lds + PG8_SA(b, h) + aoff + m * 2048 + k * 1024); } while (0)
#define PG8_LDB(dst, b, h) do { _Pragma("unroll") for (int n = 0; n < 2; ++n) _Pragma("unroll") for (int k = 0; k < 2; ++k) dst[n][k] = *(const PG8_LAS bf16x8*)(lds + PG8_SB(b, h) + boff + n * 2048 + k * 1024); } while (0)
#define PG8_MMA(ai, bj, At, Bt) do { __builtin_amdgcn_s_setprio(1); _Pragma("unroll") for (int m = 0; m < 4; ++m) _Pragma("unroll") for (int n = 0; n < 2; ++n) _Pragma("unroll") for (int k = 0; k < 2; ++k) \
        acc[ai][bj][m][n] = __builtin_amdgcn_mfma_f32_16x16x32_bf16(Bt[n][k], At[m][k], acc[ai][bj][m][n], 0, 0, 0); __builtin_amdgcn_s_setprio(0); } while (0)
#define PG8_WAIT_V(n) asm volatile("s_waitcnt vmcnt(" #n ")" ::: "memory")
#define PG8_WAIT_L(n) asm volatile("s_waitcnt lgkmcnt(" #n ")" ::: "memory")
#define PG8_BAR __builtin_amdgcn_s_barrier()
#define PG8_SCHED __builtin_amdgcn_sched_barrier(0)
    Unit cur, nxt; int ui = 0;
    if (!S.next(0, cur)) return;
    f32x4 acc[2][2][4][2];
#pragma unroll
    for (int a = 0; a < 2; ++a)
#pragma unroll
        for (int b = 0; b < 2; ++b)
#pragma unroll
            for (int m = 0; m < 4; ++m)
#pragma unroll
                for (int n = 0; n < 2; ++n) acc[a][b][m][n] = (f32x4){0.f, 0.f, 0.f, 0.f};
    bf16x8 At[4][2], B0[2][2], B1[2][2];
    const char* cA = (const char*)g.A + (size_t)cur.pm * tstep; const char* cB = (const char*)g.Bt + (size_t)cur.pn * tstep;
    S.a_ready(cur);
    if constexpr (SP2) {
        PG8_STAGE(PG8_SB(0, 0), cB, voffB); PG8_STAGE(PG8_SB(0, 1), cB + hstep, voffB); PG8_STAGE(PG8_SA(0, 0), cA, voffA); PG8_STAGE(PG8_SA(0, 1), cA + hstep, voffA);
        if (wr == 1) PG8_BAR;
        PG8_WAIT_V(2); PG8_BAR;
        PG8_STAGE(PG8_SB(1, 0), cB + kstep, voffB); PG8_STAGE(PG8_SA(1, 0), cA + kstep, voffA); PG8_STAGE(PG8_SB(1, 1), cB + hstep + kstep, voffB);
        PG8_WAIT_V(6); PG8_BAR;
    } else {
        PG8_STAGE(PG8_SB(0, 0), cB, voffB); PG8_STAGE(PG8_SA(0, 0), cA, voffA); PG8_STAGE(PG8_SB(0, 1), cB + hstep, voffB); PG8_STAGE(PG8_SA(0, 1), cA + hstep, voffA);
        if (wr == 1) PG8_BAR;
        PG8_WAIT_V(4); PG8_BAR;
        PG8_STAGE(PG8_SB(1, 0), cB + kstep, voffB); PG8_STAGE(PG8_SA(1, 0), cA + kstep, voffA); PG8_STAGE(PG8_SB(1, 1), cB + hstep + kstep, voffB);
        PG8_WAIT_V(6); PG8_BAR;
    }
    for (;;) {
        const bool has_next = S.next(ui + 1, nxt);
        const char* nA = has_next ? (const char*)g.A + (size_t)nxt.pm * tstep : cA; const char* nB = has_next ? (const char*)g.Bt + (size_t)nxt.pn * tstep : cB;
        for (int t = 0; t < nt; t += 2) {
            const bool last = (t == nt - 2);
            const char* a1 = cA + (size_t)(t + 1) * kstep;
            const char* a2 = last ? nA : cA + (size_t)(t + 2) * kstep; const char* b2 = last ? nB : cB + (size_t)(t + 2) * kstep;
            const char* a3 = a2 + kstep; const char* b3 = b2 + kstep;
            if (last && has_next) S.a_ready(nxt);
            if constexpr (SP2) {
            PG8_LDB(B0, 0, 0); PG8_LDB(B1, 0, 1); PG8_SCHED; PG8_LDA(At, 0, 0); PG8_STAGE(PG8_SA(1, 1), a1 + hstep, voffA);
            PG8_WAIT_V(8); PG8_WAIT_L(0); PG8_BAR; PG8_MMA(0, 0, At, B0); PG8_MMA(0, 1, At, B1); PG8_BAR; PG8_SCHED;
            PG8_LDA(At, 0, 1); PG8_STAGE(PG8_SB(0, 0), b2, voffB); PG8_STAGE(PG8_SB(0, 1), b2 + hstep, voffB); PG8_STAGE(PG8_SA(0, 0), a2, voffA);
            PG8_WAIT_V(8); PG8_WAIT_L(0); PG8_BAR; PG8_MMA(1, 0, At, B0); PG8_MMA(1, 1, At, B1); PG8_BAR; PG8_SCHED;
            PG8_LDB(B0, 1, 0); PG8_LDB(B1, 1, 1); PG8_SCHED; PG8_LDA(At, 1, 0); PG8_STAGE(PG8_SA(0, 1), a2 + hstep, voffA);
            PG8_WAIT_V(8); PG8_WAIT_L(0); PG8_BAR; PG8_MMA(0, 0, At, B0); PG8_MMA(0, 1, At, B1); PG8_BAR; PG8_SCHED;
            PG8_LDA(At, 1, 1); PG8_STAGE(PG8_SB(1, 0), b3, voffB); PG8_STAGE(PG8_SB(1, 1), b3 + hstep, voffB); PG8_STAGE(PG8_SA(1, 0), a3, voffA);
            PG8_WAIT_V(8); PG8_WAIT_L(0); PG8_BAR; PG8_MMA(1, 0, At, B0); PG8_MMA(1, 1, At, B1); PG8_BAR; PG8_SCHED;
            } else {
            PG8_LDB(B0, 0, 0); PG8_SCHED; PG8_LDA(At, 0, 0); PG8_STAGE(PG8_SA(1, 1), a1 + hstep, voffA);
            PG8_WAIT_L(8); PG8_BAR; PG8_WAIT_L(0); PG8_MMA(0, 0, At, B0); PG8_BAR; PG8_SCHED;
            PG8_LDB(B1, 0, 1); PG8_STAGE(PG8_SB(0, 0), b2, voffB);
            PG8_BAR; PG8_WAIT_L(0); PG8_MMA(0, 1, At, B1); PG8_BAR;
            PG8_LDA(At, 0, 1); PG8_STAGE(PG8_SA(0, 0), a2, voffA);
            PG8_BAR; PG8_WAIT_L(0); PG8_MMA(1, 0, At, B0); PG8_BAR; PG8_SCHED;
            PG8_STAGE(PG8_SB(0, 1), b2 + hstep, voffB);
            PG8_WAIT_V(6); PG8_BAR; PG8_MMA(1, 1, At, B1); PG8_BAR;
            PG8_LDB(B0, 1, 0); PG8_SCHED; PG8_LDA(At, 1, 0); PG8_STAGE(PG8_SA(0, 1), a2 + hstep, voffA);
            PG8_WAIT_L(8); PG8_BAR; PG8_WAIT_L(0); PG8_MMA(0, 0, At, B0); PG8_BAR; PG8_SCHED;
            PG8_LDB(B1, 1, 1); PG8_STAGE(PG8_SB(1, 0), b3, voffB);
            PG8_BAR; PG8_WAIT_L(0); PG8_MMA(0, 1, At, B1); PG8_BAR;
            PG8_LDA(At, 1, 1); PG8_STAGE(PG8_SA(1, 0), a3, voffA);
            PG8_BAR; PG8_WAIT_L(0); PG8_MMA(1, 0, At, B0); PG8_BAR; PG8_SCHED;
            PG8_STAGE(PG8_SB(1, 1), b3 + hstep, voffB);
            PG8_WAIT_V(6); PG8_BAR; PG8_MMA(1, 1, At, B1); PG8_BAR;
            }
        }
        if constexpr (ALIGN_EPI) { if (wr == 0) PG8_BAR; }
        if constexpr (!Epi::AFTER_DRAIN) { E(acc, cur, wr, wc, fr, fq); S.done(cur); }
        if (!has_next) break;
#pragma unroll
        for (int a = 0; a < 2; ++a)
#pragma unroll
            for (int b = 0; b < 2; ++b)
#pragma unroll
                for (int m = 0; m < 4; ++m)
#pragma unroll
                    for (int n = 0; n < 2; ++n) acc[a][b][m][n] = (f32x4){0.f, 0.f, 0.f, 0.f};
        cur = nxt; cA = nA; cB = nB; ++ui;
        if constexpr (ALIGN_EPI) { if (wr == 1) PG8_BAR; }
    }
    PG8_WAIT_V(0);
    if constexpr (!ALIGN_EPI) { if (wr == 0) PG8_BAR; }
    PG8_BAR;
    if constexpr (Epi::AFTER_DRAIN) { E.fused(acc, cur, wr, wc, fr, fq, lds, wid, lane); S.done(cur); }
#undef PG8_SA
#undef PG8_SB
#undef PG8_STAGE
#undef PG8_LDA
#undef PG8_LDB
#undef PG8_MMA
#undef PG8_WAIT_V
#undef PG8_WAIT_L
#undef PG8_BAR
#undef PG8_SCHED
}
}
#define XB_TMO      128
#define XB_XCNT(j)  (256  + 64 * (j))
#define XB_XSUB(j)  (1280 + 64 * (j))
#define XB_XGEN(j)  (2304 + 64 * (j))
#define XB_TOP      3328
#define XB_TOPGEN   3392
#define XCD_BAR_WORDS 3456
#define XB_SPIN_CAP (1u << 18)

__device__ __forceinline__ unsigned xb_ld(unsigned* p)              { return __hip_atomic_load(p, __ATOMIC_RELAXED, __HIP_MEMORY_SCOPE_AGENT); }
__device__ __forceinline__ unsigned xb_add(unsigned* p, unsigned v) { return __hip_atomic_fetch_add(p, v, __ATOMIC_RELAXED, __HIP_MEMORY_SCOPE_AGENT); }
__device__ __forceinline__ unsigned xb_xcc_id() { return (unsigned)__builtin_amdgcn_s_getreg((3 << 11) | 20) & 0xFu; }
#define XB_SPIN(cond, bar) do { unsigned _sp = 0; while (cond) { __builtin_amdgcn_s_sleep(1); \
    if ((++_sp & 255u) == 0u) { if (xb_ld(&(bar)[XB_TMO])) break; if (_sp > XB_SPIN_CAP) { atomicAdd(&(bar)[XB_TMO], 1u); break; } } } } while (0)

struct XcdBarrier {
    unsigned* bar; unsigned x;
    volatile LAS unsigned* st;
};

__device__ __forceinline__ XcdBarrier xcd_barrier_post(unsigned* bar, volatile LAS unsigned* st) {
    XcdBarrier b; b.bar = bar; b.x = xb_xcc_id(); b.st = st;
    if (threadIdx.x == 0) (void)xb_add(&bar[XB_XCNT(b.x)], 1u);
    return b;
}
__device__ __forceinline__ void xcd_barrier_complete(unsigned* bar, unsigned x, unsigned& nloc, unsigned& nx) {
    const unsigned G = gridDim.x * gridDim.y * gridDim.z;
    unsigned sum, cnt, mine, sp = 0u;
    for (;;) {
        sum = 0u; cnt = 0u; mine = 0u;
#pragma unroll
        for (unsigned j = 0; j < 16; ++j) { const unsigned c = xb_ld(&bar[XB_XCNT(j)]); sum += c; cnt += (c > 0u) ? 1u : 0u; mine = (j == x) ? c : mine; }
        if (sum == G) break;
        __builtin_amdgcn_s_sleep(1);
        if ((++sp & 255u) == 0u) { if (xb_ld(&bar[XB_TMO])) break; if (sp > XB_SPIN_CAP) { atomicAdd(&bar[XB_TMO], 1u); break; } }
    }
    nloc = mine > 0u ? mine : 1u; nx = cnt > 0u ? cnt : 1u;
}

__device__ __forceinline__ void xcd_barrier(const XcdBarrier& b) {
    asm volatile("s_waitcnt vmcnt(0)" ::: "memory");
    __syncthreads();
    if (threadIdx.x == 0) {
        unsigned* bar = b.bar;
        __builtin_amdgcn_s_waitcnt(0);
        unsigned nloc = b.st[0], nx = b.st[1];
        if (nloc == 0u) { xcd_barrier_complete(bar, b.x, nloc, nx); b.st[0] = nloc; b.st[1] = nx; }
        const unsigned old = xb_add(&bar[XB_XSUB(b.x)], 1u);
        const unsigned gen = old / nloc;
        if (old + 1u == (gen + 1u) * nloc) {
            __builtin_amdgcn_fence(__ATOMIC_RELEASE, "agent");
            asm volatile("s_waitcnt vmcnt(0)" ::: "memory");
            const unsigned og = xb_add(&bar[XB_TOP], 1u);
            const unsigned tg = og / nx;
            if (og + 1u == (tg + 1u) * nx) xb_add(&bar[XB_TOPGEN], 1u);
            else XB_SPIN(xb_ld(&bar[XB_TOPGEN]) == tg, bar);
            __builtin_amdgcn_fence(__ATOMIC_ACQUIRE, "agent");
            xb_add(&bar[XB_XGEN(b.x)], 1u);
            asm volatile("s_waitcnt vmcnt(0)" ::: "memory");
        } else {
            XB_SPIN(xb_ld(&bar[XB_XGEN(b.x)]) == gen, bar);
            __builtin_amdgcn_fence(__ATOMIC_ACQUIRE, "agent");
            asm volatile("s_waitcnt vmcnt(0)" ::: "memory");
        }
    }
    __syncthreads();
}
#ifndef MK_LO
#define MK_LO 0
#endif
#ifndef MK_HI
#define MK_HI 3
#endif
struct RotC { double nsa[16]; double swa[8]; };
struct Args { const void* in[28]; float* out; unsigned char* ws; RotC rc; };
struct Ctx { LAS unsigned char* lds; int tid, lane, wave, G, vcu; };
__device__ __forceinline__ Ctx fresh_ctx(const Ctx& C0) { Ctx C = C0; int t = threadIdx.x; asm volatile("" : "+v"(t)); C.tid = t; C.lane = t & 63; C.wave = __builtin_amdgcn_readfirstlane(t >> 6); return C; }

__device__ __forceinline__ void conv_item(const float* __restrict__ W, int K, int ldw, int col0, int nvalid, int npad, bf16* __restrict__ dst, int row_off, LAS float* scr, int item, int lane) {
    const int nblk = npad / 32, kb = item / nblk, nb = item % nblk, k0 = 64 * kb, n0 = 32 * nb, nn = n0 + (lane & 31);
    const bool ok = nn < nvalid;
#pragma unroll 8
    for (int i = 0; i < 32; ++i) { const int kk = 2 * i + (lane >> 5); scr[kk * 33 + (lane & 31)] = ok ? W[(size_t)(k0 + kk) * ldw + col0 + nn] : 0.f; }
    LDS_WAIT(); asm volatile("" ::: "memory");
    const int c = lane & 7;
#pragma unroll
    for (int j = 0; j < 4; ++j) { const int n = (lane >> 3) + 8 * j; const LAS float* s = scr + (8 * c) * 33 + n;
        v4u o; o.x = pkbf(s[0 * 33], s[1 * 33]); o.y = pkbf(s[2 * 33], s[3 * 33]); o.z = pkbf(s[4 * 33], s[5 * 33]); o.w = pkbf(s[6 * 33], s[7 * 33]);
        *(v4u*)(dst + (size_t)(row_off + n0 + n) * K + k0 + 8 * c) = o; }
    LDS_WAIT(); asm volatile("" ::: "memory");
}
#define CONV_JOB(W_, K_, LDW_, COL0_, NV_, NP_, DST_, RO_) { const int ni_ = ((K_) / 64) * ((NP_) / 32); if (r < ni_) { conv_item((const float*)(W_), (K_), (LDW_), (COL0_), (NV_), (NP_), (bf16*)(DST_), (RO_), scr, r, C.lane); continue; } r -= ni_; }
__device__ __forceinline__ void conv_layer(const Ctx& C0, const Args& A, int layer) {
    const Ctx C = fresh_ctx(C0);
    LAS float* scr = (LAS float*)(C.lds + C.wave * 8704);
    const int gw = C.vcu * NWAVES + C.wave, NGW = C.G * NWAVES;
    unsigned char* ws = A.ws;
    if (layer == 0 || layer == 3) {
        const int b = layer == 0 ? 3 : 23;
        for (int it = gw; it < 8192 + 2048; it += NGW) { int r = it;
            CONV_JOB(A.in[b], 2048, 8192, 0, 8192, 8192, ws + WS_WIN, 0)
            CONV_JOB(A.in[b + 2], 2048, 2048, 0, 2048, 2048, ws + WS_WOUT, 0) }
    } else if (layer == 1) {
        for (int it = gw; it < 2048 + 3072 + 2048 + 64 + 512 + 512 + 16 + 16 + 2048; it += NGW) { int r = it;
            CONV_JOB(A.in[8], 2048, 7216, 0, 2048, 2048, ws + WS_WIN, 0)
            CONV_JOB(A.in[8], 2048, 7216, 2048, 3072, 3072, ws + WS_WIN, 2048)
            CONV_JOB(A.in[8], 2048, 7216, 5168, 2048, 2048, ws + WS_WIN, 5120)
            CONV_JOB(A.in[8], 2048, 7216, 5120, 48, 64, ws + WS_WIN, 7168)
            CONV_JOB(A.in[10], 4096, 256, 0, 256, 256, ws + WS_W1TK, 0)
            CONV_JOB(A.in[13], 4096, 256, 0, 256, 256, ws + WS_W1TV, 0)
            CONV_JOB(A.in[11], 256, 128, 0, 128, 128, ws + WS_W2TK, 0)
            CONV_JOB(A.in[14], 256, 128, 0, 128, 128, ws + WS_W2TV, 0)
            CONV_JOB(A.in[15], 2048, 2048, 0, 2048, 2048, ws + WS_WOUT, 0) }
    } else {
        for (int it = gw; it < 4608 + 2048; it += NGW) { int r = it;
            CONV_JOB(A.in[18], 2048, 4608, 0, 4608, 4608, ws + WS_WIN, 0)
            CONV_JOB(A.in[20], 2048, 2048, 0, 2048, 2048, ws + WS_WOUT, 0) }
    }
}
__device__ __forceinline__ void p0_misc(const Ctx& C0, const Args& A) {
    const Ctx C = fresh_ctx(C0);
    unsigned char* ws = A.ws;
    const size_t gt = (size_t)C.vcu * 512 + C.tid, NT = (size_t)C.G * 512;
    { const float* x = MK_LO == 0 ? (const float*)A.in[0] : (const float*)A.out; bf16* hb = (bf16*)(ws + WS_HB);
      for (size_t i = gt; i < (size_t)S * DM / 8; i += NT) { const f32x4 a = *(const f32x4*)(x + i * 8), b = *(const f32x4*)(x + i * 8 + 4); v4u o; o.x = pkbf(a[0], a[1]); o.y = pkbf(a[2], a[3]); o.z = pkbf(b[0], b[1]); o.w = pkbf(b[2], b[3]); *(v4u*)(hb + i * 8) = o; } }
    { const int* pos = (const int*)A.in[1]; float* cn = (float*)(ws + WS_COSN); float* sn = (float*)(ws + WS_SINN); float* cw = (float*)(ws + WS_COSW); float* sw = (float*)(ws + WS_SINW);
      for (size_t idx = gt; idx < (size_t)S * 24; idx += NT) { const int t = (int)(idx / 24), i = (int)(idx % 24); const double f = i < 16 ? A.rc.nsa[i < 16 ? i : 0] : A.rc.swa[i >= 16 ? i - 16 : 0];
          double r = (double)pos[t] * f; r -= floor(r); const float a = (float)(r * 6.283185307179586); const float c = cosf(a), s = sinf(a);
          if (i < 16) { cn[t * 16 + i] = c; sn[t * 16 + i] = s; } else { cw[t * 8 + i - 16] = c; sw[t * 8 + i - 16] = s; } } }
    { const float* lg = (const float*)A.in[2]; float* lbt = (float*)(ws + WS_LB);
      for (size_t c = gt; c < DM; c += NT) { const float a = lg[c], b = lg[DM + c], m = fmaxf(a, b), ea = expf(a - m), eb = expf(b - m), s = ea + eb; const float p0 = ea / s, p1 = eb / s, lb = (p0 + p1) - p0; lbt[c] = lb; } }
    { float* c1p = (float*)(ws + WS_C1P); LAS float* red = (LAS float*)(C.lds + 120000);
      for (int it = C.vcu; it < 128; it += C.G) { const int which = it >> 6, part = it & 63, n = C.tid & 255, half = C.tid >> 8;
          const float* pos = (const float*)A.in[which ? 12 : 9]; const float* w1 = (const float*)A.in[which ? 13 : 10]; float a = 0.f;
          for (int kk = part * 64 + half * 32; kk < part * 64 + half * 32 + 32; ++kk) a = fmaf(pos[kk], w1[(size_t)kk * 256 + n], a);
          if (half) red[n] = a; __syncthreads(); if (!half) c1p[(size_t)it * 256 + n] = a + red[n]; __syncthreads(); } }
}
__device__ __forceinline__ void ln_phase(const Ctx& C0, float* H, bf16* HB, const float* __restrict__ g, const float* __restrict__ b, bool write_hb) {
    const Ctx C = fresh_ctx(C0);
    const int gw = C.vcu * NWAVES + C.wave, NGW = C.G * NWAVES;
    for (int m = gw; m < S; m += NGW) {
        f32x4* xr = (f32x4*)(H + (size_t)m * DM) + C.lane; f32x4 v[8]; float s = 0.f;
#pragma unroll
        for (int j = 0; j < 8; ++j) { v[j] = xr[64 * j]; s += (v[j][0] + v[j][1]) + (v[j][2] + v[j][3]); }
#pragma unroll
        for (int o = 1; o < 64; o <<= 1) s += __shfl_xor(s, o);
        const float mean = s * (1.f / DM); float q = 0.f;
#pragma unroll
        for (int j = 0; j < 8; ++j) { v[j] = v[j] - mean; q += (v[j][0] * v[j][0] + v[j][1] * v[j][1]) + (v[j][2] * v[j][2] + v[j][3] * v[j][3]); }
#pragma unroll
        for (int o = 1; o < 64; o <<= 1) q += __shfl_xor(q, o);
        const float rstd = 1.f / sqrtf(q * (1.f / DM) + LN_EPS);
        v2u* hb = (v2u*)(HB + (size_t)m * DM) + C.lane;
#pragma unroll
        for (int j = 0; j < 8; ++j) { const f32x4 gg = ((const f32x4*)g)[64 * j + C.lane], bb = ((const f32x4*)b)[64 * j + C.lane]; const f32x4 o = v[j] * rstd * gg + bb; xr[64 * j] = o; if (write_hb) hb[64 * j] = pk4(o); }
    }
}

__device__ __forceinline__ void hgx_unit(const Ctx& C0, unsigned char* ws, int c, int h) {
    const Ctx C = fresh_ctx(C0);
    LAS unsigned char* lds = C.lds;
    LAS float* Gs = (LAS float*)lds; LAS float* tot = (LAS float*)(lds + 32768);
    LAS unsigned char* QT = lds + 36864; LAS unsigned char* KT = lds + 53248; LAS unsigned char* KE = lds + 69632; LAS unsigned char* VT = lds + 86016;
    const int tid = C.tid, lane = C.lane, w = C.wave; const size_t rowbase = (size_t)c * 64; const int unit = c * 16 + h;
    bf16* QB = (bf16*)(ws + WS_QB); const float* GB = (const float*)(ws + WS_GB); const bf16* VB = (const bf16*)(ws + WS_VB);
#pragma unroll
    for (int i = 0; i < 4; ++i) { const int idx = tid + 512 * i, t = idx >> 5, c4 = idx & 31; *(LAS f32x4*)(Gs + t * 128 + c4 * 4) = *(const f32x4*)(GB + (rowbase + t) * DM + h * 128 + c4 * 4); }
    __syncthreads();
    { const int k = tid & 127, part = tid >> 7; float run = 0.f;
#pragma unroll
      for (int i = 0; i < 16; ++i) { const int t = part * 16 + i; run += Gs[t * 128 + k]; Gs[t * 128 + k] = run; }
      tot[part * 128 + k] = run; }
    __syncthreads();
    { const int k = tid & 127, part = tid >> 7; float off = 0.f;
      for (int p = 0; p < part; ++p) off += tot[p * 128 + k];
      if (part > 0) {
#pragma unroll
          for (int i = 0; i < 16; ++i) Gs[(part * 16 + i) * 128 + k] += off; } }
    __syncthreads();
#pragma unroll
    for (int it = 0; it < 2; ++it) {
        const int id = tid + 512 * it, t = id >> 4, kc = id & 15;
        bf16* qp = QB + (rowbase + t) * DM + h * 128 + kc * 8;
        const v4u q8 = *(const v4u*)qp; const v4u v8 = *(const v4u*)(VB + (rowbase + t) * DM + h * 128 + kc * 8);
        float b[8], bp[8], bm[8], be[8];
#pragma unroll
        for (int j = 0; j < 8; ++j) { b[j] = Gs[t * 128 + kc * 8 + j]; bp[j] = t > 0 ? Gs[(t - 1) * 128 + kc * 8 + j] : 0.f; bm[j] = Gs[31 * 128 + kc * 8 + j]; be[j] = Gs[63 * 128 + kc * 8 + j]; }
        float qt[8], kt[8], qb[8], ke[8];
#pragma unroll
        for (int j = 0; j < 8; ++j) { const unsigned wq = j < 2 ? q8.x : j < 4 ? q8.y : j < 6 ? q8.z : q8.w; const float q = (j & 1) ? bfhi(wq) : bflo(wq);
            const float kk = -expm1f(b[j] - bp[j]);
            qt[j] = q * __expf(fminf(b[j] - bm[j], 80.f)); kt[j] = kk * __expf(fminf(bm[j] - b[j], 80.f)); qb[j] = q * __expf(b[j]); ke[j] = kk * __expf(be[j] - b[j]); }
        v4u o; o.x = pkbf(qt[0], qt[1]); o.y = pkbf(qt[2], qt[3]); o.z = pkbf(qt[4], qt[5]); o.w = pkbf(qt[6], qt[7]);
        *(LAS v4u*)(QT + t * 256 + ((kc ^ (t & 15)) << 4)) = o;
        o.x = pkbf(kt[0], kt[1]); o.y = pkbf(kt[2], kt[3]); o.z = pkbf(kt[4], kt[5]); o.w = pkbf(kt[6], kt[7]);
        *(LAS v4u*)(KT + t * 256 + ((kc ^ (t & 15)) << 4)) = o;
        o.x = pkbf(qb[0], qb[1]); o.y = pkbf(qb[2], qb[3]); o.z = pkbf(qb[4], qb[5]); o.w = pkbf(qb[6], qb[7]);
        *(v4u*)qp = o;
#pragma unroll
        for (int j = 0; j < 8; ++j) { const int k = kc * 8 + j; const unsigned wv = j < 2 ? v8.x : j < 4 ? v8.y : j < 6 ? v8.z : v8.w;
            *(LAS unsigned short*)(KE + k * 128 + (((t >> 3) ^ ((k >> 1) & 7)) << 4) + (t & 7) * 2) = (unsigned short)(pkbf(ke[j], 0.f) & 0xffffu);
            *(LAS unsigned short*)(VT + k * 128 + (((t >> 3) ^ ((k >> 1) & 7)) << 4) + (t & 7) * 2) = (unsigned short)((j & 1) ? (wv >> 16) : (wv & 0xffffu)); }
    }
    if (tid < 128) ((float*)(ws + WS_DD))[(size_t)unit * 128 + tid] = __expf(Gs[63 * 128 + tid]);
    __syncthreads();
    const int l15 = lane & 15, l4 = lane >> 4;
    {
        bf16* AM = (bf16*)(ws + WS_AM) + (size_t)unit * 4096; const int tn = w & 3;
        bf16x8 bq[4];
#pragma unroll
        for (int ks = 0; ks < 4; ++ks) { const int row = 16 * tn + l15; bq[ks] = ld_frag(QT + row * 256 + (((ks * 4 + l4) ^ (row & 15)) << 4)); }
#pragma unroll
        for (int i = 0; i < 2; ++i) { const int sm = 2 * (w >> 2) + i; f32x4 acc = {0.f, 0.f, 0.f, 0.f};
#pragma unroll
            for (int ks = 0; ks < 4; ++ks) { const int row = 16 * sm + l15; acc = mfma16(ld_frag(KT + row * 256 + (((ks * 4 + l4) ^ (row & 15)) << 4)), bq[ks], acc); }
            const int t = 16 * tn + l15, s0 = 16 * sm + 4 * l4;
#pragma unroll
            for (int e = 0; e < 4; ++e) if (s0 + e > t) acc[e] = 0.f;
            *(v2u*)(AM + t * 64 + s0) = pk4(acc); }
    }
    {
        bf16* UT = (bf16*)(ws + WS_UT) + (size_t)unit * 16384; const int vrow = 16 * w + l15;
        bf16x8 bv[2];
#pragma unroll
        for (int ks = 0; ks < 2; ++ks) bv[ks] = ld_frag(VT + vrow * 128 + (((ks * 4 + l4) ^ ((vrow >> 1) & 7)) << 4));
#pragma unroll
        for (int km = 0; km < 8; ++km) { f32x4 acc = {0.f, 0.f, 0.f, 0.f}; const int krow = 16 * km + l15;
#pragma unroll
            for (int ks = 0; ks < 2; ++ks) acc = mfma16(ld_frag(KE + krow * 128 + (((ks * 4 + l4) ^ ((krow >> 1) & 7)) << 4)), bv[ks], acc);
            *(v2u*)(UT + vrow * 128 + 16 * km + 4 * l4) = pk4(acc); }
    }
    __syncthreads();
}

constexpr int RB = 41984;
__device__ __forceinline__ void hgr_head(const Ctx& C0, unsigned char* ws, int h, const float* __restrict__ gnorm) {
    const Ctx C = fresh_ctx(C0);
    LAS unsigned char* lds = C.lds; const int tid = C.tid, lane = C.lane, w = C.wave, l15 = lane & 15, l4 = lane >> 4;
    const bf16* QB = (const bf16*)(ws + WS_QB); const bf16* VB = (const bf16*)(ws + WS_VB); const bf16* ZS = (const bf16*)(ws + WS_ZS); bf16* HB = (bf16*)(ws + WS_HB);
    const bf16* AMg = (const bf16*)(ws + WS_AM); const bf16* UTg = (const bf16*)(ws + WS_UT); const float* DDg = (const float*)(ws + WS_DD);
    LAS float* red = (LAS float*)(lds + 2 * RB);
    LAS float* rtab = (LAS float*)(lds + 2 * RB + 4096);
    float st[4][8];
#pragma unroll
    for (int a = 0; a < 4; ++a)
#pragma unroll
        for (int j = 0; j < 8; ++j) st[a][j] = 0.f;
    const int vcol = h * 128 + 16 * w + l15; const float gn = gnorm[vcol];
    v4u rq[2], rv[2], ra, rd;
#define HGR_LOAD(cc) do { const size_t rb_ = (size_t)(cc) * 64; const int un_ = (cc) * 16 + h; \
        _Pragma("unroll") for (int it = 0; it < 2; ++it) { const int id = tid + 512 * it, t = id >> 4, c16 = id & 15; rq[it] = *(const v4u*)(QB + (rb_ + t) * DM + h * 128 + c16 * 8); rv[it] = *(const v4u*)(VB + (rb_ + t) * DM + h * 128 + c16 * 8); } \
        ra = *(const v4u*)(AMg + (size_t)un_ * 4096 + tid * 8); if (tid < 32) rd = *(const v4u*)(DDg + (size_t)un_ * 128 + tid * 4); } while (0)
#define HGR_WRITE(bufp) do { LAS unsigned char* b_ = (bufp); \
        _Pragma("unroll") for (int it = 0; it < 2; ++it) { const int id = tid + 512 * it, t = id >> 4, c16 = id & 15; *(LAS v4u*)(b_ + t * 256 + ((c16 ^ (t & 15)) << 4)) = rq[it]; \
            *(LAS v4u*)(b_ + 24576 + t * 256 + ((((c16 >> 1) ^ ((t & 3) | (((t >> 3) & 1) << 2))) << 5) | ((c16 & 1) << 4))) = rv[it]; } \
        { const int t = tid >> 3, c8 = tid & 7; *(LAS v4u*)(b_ + 16384 + t * 128 + ((c8 ^ ((t >> 1) & 7)) << 4)) = ra; } \
        if (tid < 32) *(LAS v4u*)(b_ + 40960 + tid * 16) = rd; } while (0)
    HGR_LOAD(0); HGR_WRITE(lds); __syncthreads();
    for (int c = 0; c < 128; ++c) {
        LAS unsigned char* buf = lds + (c & 1) * RB; const int unit = c * 16 + h;
        if (c + 1 < 128) HGR_LOAD(c + 1);
        v4u u8[4];
#pragma unroll
        for (int ks = 0; ks < 4; ++ks) u8[ks] = *(const v4u*)(UTg + (size_t)unit * 16384 + (16 * w + l15) * 128 + 32 * ks + 8 * l4);
        f32x4 o[4];
#pragma unroll
        for (int m = 0; m < 4; ++m) o[m] = (f32x4){0.f, 0.f, 0.f, 0.f};
#pragma unroll
        for (int ks = 0; ks < 4; ++ks) { v4u sp; sp.x = pkbf(st[ks][0], st[ks][1]); sp.y = pkbf(st[ks][2], st[ks][3]); sp.z = pkbf(st[ks][4], st[ks][5]); sp.w = pkbf(st[ks][6], st[ks][7]);
            const bf16x8 sf = __builtin_bit_cast(bf16x8, sp);
#pragma unroll
            for (int m = 0; m < 4; ++m) { const int row = 16 * m + l15; o[m] = mfma16(ld_frag(buf + row * 256 + (((ks * 4 + l4) ^ (row & 15)) << 4)), sf, o[m]); } }
#pragma unroll
        for (int ss = 0; ss < 2; ++ss) {
            const int q = l15 >> 2, p = l15 & 3; const int s_lo = 32 * ss + 8 * l4 + q, s_hi = s_lo + 4;
            const s16x4 lo = tr_rd(buf + 24576 + s_lo * 256 + ((w ^ ((s_lo & 3) | (((s_lo >> 3) & 1) << 2))) << 5) + p * 8);
            const s16x4 hi = tr_rd(buf + 24576 + s_hi * 256 + ((w ^ ((s_hi & 3) | (((s_hi >> 3) & 1) << 2))) << 5) + p * 8);
            const bf16x8 vf = __builtin_shufflevector(lo, hi, 0, 1, 2, 3, 4, 5, 6, 7);
#pragma unroll
            for (int m = 0; m < 4; ++m) { const int row = 16 * m + l15; o[m] = mfma16(ld_frag(buf + 16384 + row * 128 + (((ss * 4 + l4) ^ ((row >> 1) & 7)) << 4)), vf, o[m]); } }
#pragma unroll
        for (int ks = 0; ks < 4; ++ks) { const f32x4 d0 = *(const LAS f32x4*)(buf + 40960 + (32 * ks + 8 * l4) * 4), d1 = *(const LAS f32x4*)(buf + 40960 + (32 * ks + 8 * l4 + 4) * 4);
            const unsigned uw[4] = {u8[ks].x, u8[ks].y, u8[ks].z, u8[ks].w};
#pragma unroll
            for (int j = 0; j < 8; ++j) { const float d = j < 4 ? d0[j & 3] : d1[j & 3]; const float u = (j & 1) ? bfhi(uw[j >> 1]) : bflo(uw[j >> 1]); st[ks][j] = fmaf(d, st[ks][j], u); } }
#pragma unroll
        for (int m = 0; m < 4; ++m)
#pragma unroll
            for (int e = 0; e < 4; ++e) { float sq = o[m][e] * o[m][e]; sq += __shfl_xor(sq, 1); sq += __shfl_xor(sq, 2); sq += __shfl_xor(sq, 4); sq += __shfl_xor(sq, 8);
                if (l15 == 0) red[(c & 1) * 512 + (16 * m + 4 * l4 + e) * 8 + w] = sq; }
        if (c + 1 < 128) HGR_WRITE(lds + ((c + 1) & 1) * RB);
        __syncthreads();
        if (tid < 64) { const f32x4 a = *(const LAS f32x4*)(red + (c & 1) * 512 + tid * 8), b = *(const LAS f32x4*)(red + (c & 1) * 512 + tid * 8 + 4);
            const float s = ((a[0] + a[1]) + (a[2] + a[3])) + ((b[0] + b[1]) + (b[2] + b[3])); rtab[(c & 1) * 64 + tid] = 1.f / sqrtf(s * (1.f / 128.f) + RMS_EPS); }
        __syncthreads();
#pragma unroll
        for (int m = 0; m < 4; ++m) { const f32x4 ri = *(const LAS f32x4*)(rtab + (c & 1) * 64 + 16 * m + 4 * l4);
#pragma unroll
            for (int e = 0; e < 4; ++e) { const size_t off = ((size_t)c * 64 + 16 * m + 4 * l4 + e) * DM + vcol; const float z = bf2f(ZS[off]);
                HB[off] = (unsigned short)(pkbf(o[m][e] * ri[e] * gn * z, 0.f) & 0xffffu); } }
    }
#undef HGR_LOAD
#undef HGR_WRITE
    __syncthreads();
}

__device__ __forceinline__ void nsa_cmp_unit(const Ctx& C0, unsigned char* ws, int unit) {
    const Ctx C = fresh_ctx(C0);
    LAS unsigned char* lds = C.lds; const int tid = C.tid, lane = C.lane, w = C.wave, l15 = lane & 15, l4 = lane >> 4;
    const int which = unit >> 7, mt = unit & 127;
    const bf16* Asrc = (const bf16*)(ws + WS_KV + (size_t)which * KV_SLOT) + (size_t)mt * 16 * 2048;
    const bf16* W1T = (const bf16*)(ws + (which ? WS_W1TV : WS_W1TK)); const bf16* W2T = (const bf16*)(ws + (which ? WS_W2TV : WS_W2TK));
    const float* c1p = (const float*)(ws + WS_C1P) + (size_t)which * 64 * 256;
    LAS unsigned char* As = lds; LAS unsigned char* Hs = lds + 69632; LAS float* c1s = (LAS float*)(lds + 77824);
    for (int idx = tid; idx < 4352; idx += 512) { const int T = idx >> 4, c16 = idx & 15; v4u x = {0u, 0u, 0u, 0u}; if (mt * 256 + T < 4 * S) x = *(const v4u*)(Asrc + (size_t)idx * 8);
        *(LAS v4u*)(As + T * 256 + ((c16 ^ ((T >> 4) & 15)) << 4)) = x; }
    if (tid < 256) { float a = 0.f; for (int p = 0; p < 64; ++p) a += c1p[p * 256 + tid]; c1s[tid] = a; }
    __syncthreads();
    f32x4 acc[2] = {{0.f, 0.f, 0.f, 0.f}, {0.f, 0.f, 0.f, 0.f}};
    const bf16* b0p = W1T + (size_t)(32 * w + l15) * 4096 + 8 * l4; const bf16* b1p = b0p + (size_t)16 * 4096;
#pragma unroll 4
    for (int ks = 0; ks < 128; ++ks) { const int T = 16 * l15 + (ks >> 2), c16 = (ks & 3) * 4 + l4;
        const bf16x8 a = ld_frag(As + T * 256 + ((c16 ^ ((T >> 4) & 15)) << 4));
        acc[0] = mfma16(a, *(const bf16x8*)(b0p + ks * 32), acc[0]); acc[1] = mfma16(a, *(const bf16x8*)(b1p + ks * 32), acc[1]); }
#pragma unroll
    for (int nt = 0; nt < 2; ++nt) { const int n = 32 * w + 16 * nt + l15; const float cc = c1s[n];
#pragma unroll
        for (int e = 0; e < 4; ++e) { const int m = 4 * l4 + e; *(LAS unsigned short*)(Hs + m * 512 + ((((n >> 3) ^ m) & 31) << 4) + (n & 7) * 2) = (unsigned short)(pkbf(fsilu(acc[nt][e] + cc), 0.f) & 0xffffu); } }
    __syncthreads();
    f32x4 a2 = {0.f, 0.f, 0.f, 0.f};
#pragma unroll
    for (int ks = 0; ks < 8; ++ks) a2 = mfma16(ld_frag(Hs + l15 * 512 + ((((ks * 4 + l4) ^ l15) & 31) << 4)), *(const bf16x8*)(W2T + (size_t)(16 * w + l15) * 256 + ks * 32 + 8 * l4), a2);
    bf16* CB = (bf16*)(ws + WS_CB) + ((size_t)which * 2048 + 16 * mt) * 128;
#pragma unroll
    for (int e = 0; e < 4; ++e) CB[(4 * l4 + e) * 128 + 16 * w + l15] = (((16 * mt + 4 * l4 + e) & 511) == 511) ? (unsigned short)0 : (unsigned short)(pkbf(a2[e], 0.f) & 0xffffu);
    __syncthreads();
}

template <int DT> struct StageRegs { v4u k[DT / 2]; v4u v[DT / 2]; };
template <int DT> __device__ __forceinline__ void stage_load(StageRegs<DT>& R, const bf16* Kg, const bf16* Vg, size_t key0, int tid, bool withv) {
    constexpr int CPR = DT * 4;
#pragma unroll
    for (int it = 0; it < DT / 2; ++it) { const int idx = tid + 512 * it, key = idx / CPR, c = idx % CPR; R.k[it] = *(const v4u*)(Kg + (key0 + key) * (DT * 32) + c * 8); if (withv) R.v[it] = *(const v4u*)(Vg + (key0 + key) * (DT * 32) + c * 8); }
}
template <int DT> __device__ __forceinline__ void stage_write(const StageRegs<DT>& R, LAS unsigned char* Kt, LAS unsigned char* Vt, int tid, bool withv) {
    constexpr int CPR = DT * 4;
#pragma unroll
    for (int it = 0; it < DT / 2; ++it) { const int idx = tid + 512 * it, key = idx / CPR, c = idx % CPR;
        const int ka = DT == 4 ? key * 256 + ((c ^ (key & 15)) << 4) : key * 128 + ((c ^ ((key >> 1) & 7)) << 4);
        *(LAS v4u*)(Kt + ka) = R.k[it]; if (withv) *(LAS v4u*)(Vt + (c >> 2) * 4096 + key * 64 + (c & 3) * 16) = R.v[it]; }
}
template <int DT> __device__ __forceinline__ void qk_tile(f32x16 (&p)[2], const bf16x8 (&qf)[2 * DT], const LAS unsigned char* Kt, int r32, int hi) {
#pragma unroll
    for (int kt = 0; kt < 2; ++kt)
#pragma unroll
        for (int i = 0; i < 16; ++i) p[kt][i] = 0.f;
#pragma unroll
    for (int s = 0; s < 2 * DT; ++s)
#pragma unroll
        for (int kt = 0; kt < 2; ++kt) { const int key = 32 * kt + r32; const int ka = DT == 4 ? key * 256 + (((2 * s + hi) ^ (key & 15)) << 4) : key * 128 + (((2 * s + hi) ^ ((key >> 1) & 7)) << 4);
            p[kt] = mfma32(ld_frag(Kt + ka), qf[s], p[kt]); }
}
template <int DT> __device__ __forceinline__ void pv_tile(f32x16 (&o)[DT], const f32x16 (&p)[2], const LAS unsigned char* Vt, int lane) {
    bf16x8 pf[4];
#pragma unroll
    for (int s = 0; s < 4; ++s) { const int b = 8 * (s & 1); v4u x; x.x = pkbf(p[s >> 1][b], p[s >> 1][b + 1]); x.y = pkbf(p[s >> 1][b + 2], p[s >> 1][b + 3]); x.z = pkbf(p[s >> 1][b + 4], p[s >> 1][b + 5]); x.w = pkbf(p[s >> 1][b + 6], p[s >> 1][b + 7]); pf[s] = __builtin_bit_cast(bf16x8, x); }
    const int i16 = lane & 15, base = (4 * (lane >> 5) + (i16 >> 2)) * 64 + ((lane >> 4) & 1) * 32 + (i16 & 3) * 8;
#pragma unroll
    for (int dt = 0; dt < DT; ++dt)
#pragma unroll
        for (int s = 0; s < 4; ++s) { const s16x4 lo = tr_rd(Vt + dt * 4096 + s * 1024 + base), hi = tr_rd(Vt + dt * 4096 + s * 1024 + 512 + base);
            o[dt] = mfma32(__builtin_shufflevector(lo, hi, 0, 1, 2, 3, 4, 5, 6, 7), pf[s], o[dt]); }
}
template <int DT> __device__ __forceinline__ void online_update(f32x16 (&o)[DT], float& m, float& l, f32x16 (&p)[2], const LAS unsigned char* Vt, int lane) {
    float tm = NEG_INF;
#pragma unroll
    for (int kt = 0; kt < 2; ++kt)
#pragma unroll
        for (int i = 0; i < 16; ++i) tm = fmaxf(tm, p[kt][i]);
    tm = swap_max(tm);
    const float mnew = fmaxf(m, tm), msafe = mnew == NEG_INF ? 0.f : mnew, alpha = __builtin_amdgcn_exp2f(m - msafe);
    float ls = 0.f;
#pragma unroll
    for (int kt = 0; kt < 2; ++kt)
#pragma unroll
        for (int i = 0; i < 16; ++i) { p[kt][i] = __builtin_amdgcn_exp2f(p[kt][i] - msafe); ls += p[kt][i]; }
    l = l * alpha + ls; m = mnew;
#pragma unroll
    for (int dt = 0; dt < DT; ++dt)
#pragma unroll
        for (int i = 0; i < 16; ++i) o[dt][i] *= alpha;
    pv_tile<DT>(o, p, Vt, lane);
}

#ifdef DBG_NAN
#define DBG_CHECK(B, SC) do { bool bad_ = !(fabsf(SC) < 1e30f); _Pragma("unroll") for (int dt_ = 0; dt_ < 4; ++dt_) _Pragma("unroll") for (int i_ = 0; i_ < 16; ++i_) bad_ |= !(fabsf(o[dt_][i_]) < 1e30f); \
    if (bad_) { atomicAdd((unsigned*)(ws + WS_CTL) + 8192 + (B), 1u); SC = 0.f; _Pragma("unroll") for (int dt_ = 0; dt_ < 4; ++dt_) _Pragma("unroll") for (int i_ = 0; i_ < 16; ++i_) o[dt_][i_] = 0.f; } } while (0)
#define DBG_BF(x) ((((x) & 0x7f80u) == 0x7f80u) || ((((x) >> 16) & 0x7f80u) == 0x7f80u))
#define DBG_KV() do { bool bk_ = false, bv_ = false; _Pragma("unroll") for (int it_ = 0; it_ < 2; ++it_) { bk_ |= DBG_BF(R.k[it_].x) || DBG_BF(R.k[it_].y) || DBG_BF(R.k[it_].z) || DBG_BF(R.k[it_].w); bv_ |= DBG_BF(R.v[it_].x) || DBG_BF(R.v[it_].y) || DBG_BF(R.v[it_].z) || DBG_BF(R.v[it_].w); } \
    if (bk_) atomicAdd((unsigned*)(ws + WS_CTL) + 8192 + 1, 1u); if (bv_) atomicAdd((unsigned*)(ws + WS_CTL) + 8192 + 2, 1u); } while (0)
#else
#define DBG_CHECK(B, SC) do {} while (0)
#define DBG_KV() do {} while (0)
#endif
__device__ __forceinline__ void nsa_attn_unit(const Ctx& C0, unsigned char* ws, int blk, int g) {
    const Ctx C = fresh_ctx(C0);
    LAS unsigned char* lds = C.lds; const int tid = C.tid, lane = C.lane, w = C.wave, r32 = lane & 31, hi = lane >> 5;
    LAS float* IMP = (LAS float*)(lds + 65536); LAS unsigned* SEL = (LAS unsigned*)(lds + 98304); LAS unsigned* UNI = (LAS unsigned*)(lds + 99328); LAS float* EV = (LAS float*)(lds + 99584) + w * 128;
    const int ql = 8 * w + (r32 >> 2), head = 4 * g + (r32 & 3), t = 64 * blk + ql;
    const bf16* QB = (const bf16*)(ws + WS_QB); const float* GATE = (const float*)(ws + WS_GATE); const bf16* ZS = (const bf16*)(ws + WS_ZS); bf16* HB = (bf16*)(ws + WS_HB);
    bf16x8 qf[8];
#pragma unroll
    for (int s = 0; s < 8; ++s) qf[s] = *(const bf16x8*)(QB + (size_t)t * DM + head * 128 + 16 * s + 8 * hi);
    for (int i = tid; i < 8192; i += 512) IMP[i] = 0.f;
    const float gate_c = GATE[(size_t)t * 48 + head], gate_s = GATE[(size_t)t * 48 + 16 + head], gate_w = GATE[(size_t)t * 48 + 32 + head];
    f32x16 o[4], p[2];
    float* ACC = (float*)(ws + WS_ACC) + (size_t)t * DM + head * 128 + 4 * hi;
    StageRegs<4> R;
    {
        const bf16* Kc = (const bf16*)(ws + WS_CB) + (size_t)g * 512 * 128; const bf16* Vc = (const bf16*)(ws + WS_CB) + (size_t)(4 + g) * 512 * 128;
        const int nmaxq = t >= 31 ? (t - 31) >> 4 : -1, ntc = ((4 * blk + 2) >> 6) + 1;
        float m = NEG_INF, l = 0.f;
        stage_load<4>(R, Kc, Vc, 0, tid, false); stage_write<4>(R, lds, lds + 16384, tid, false); __syncthreads();
        for (int i = 0; i < ntc; ++i) { LAS unsigned char* Kt = lds + (i & 1) * 32768;
            if (i + 1 < ntc) stage_load<4>(R, Kc, Vc, (size_t)(i + 1) * 64, tid, false);
            qk_tile<4>(p, qf, Kt, r32, hi);
            float tm = NEG_INF;
#pragma unroll
            for (int kt = 0; kt < 2; ++kt)
#pragma unroll
                for (int e = 0; e < 16; ++e) { if (64 * i + 32 * kt + crow(e, hi) > nmaxq) p[kt][e] = NEG_INF; tm = fmaxf(tm, p[kt][e]); }
            tm = swap_max(tm);
            const float mnew = fmaxf(m, tm), msafe = mnew == NEG_INF ? 0.f : mnew; float ls = 0.f;
#pragma unroll
            for (int kt = 0; kt < 2; ++kt)
#pragma unroll
                for (int e = 0; e < 16; ++e) ls += __builtin_amdgcn_exp2f(p[kt][e] - msafe);
            l = l * __builtin_amdgcn_exp2f(m - msafe) + ls; m = mnew;
            if (i + 1 < ntc) stage_write<4>(R, lds + ((i + 1) & 1) * 32768, lds + ((i + 1) & 1) * 32768 + 16384, tid, false);
            __syncthreads(); }
        l = swap_sum(l);
        const float msafe = m == NEG_INF ? 0.f : m, invl = 1.f / fmaxf(l, 1e-30f);
#pragma unroll
        for (int dt = 0; dt < 4; ++dt)
#pragma unroll
            for (int i = 0; i < 16; ++i) o[dt][i] = 0.f;
        float carry = 0.f;
        stage_load<4>(R, Kc, Vc, 0, tid, true); DBG_KV(); stage_write<4>(R, lds, lds + 16384, tid, true); __syncthreads();
        for (int i = 0; i < ntc; ++i) { LAS unsigned char* Kt = lds + (i & 1) * 32768;
            if (i + 1 < ntc) { stage_load<4>(R, Kc, Vc, (size_t)(i + 1) * 64, tid, true); DBG_KV(); }
            qk_tile<4>(p, qf, Kt, r32, hi);
#pragma unroll
            for (int kt = 0; kt < 2; ++kt) {
#pragma unroll
                for (int e = 0; e < 16; ++e) p[kt][e] = (64 * i + 32 * kt + crow(e, hi) > nmaxq) ? 0.f : __builtin_amdgcn_exp2f(p[kt][e] - msafe) * invl;
                float own[4], rcv[4], tot[4];
#pragma unroll
                for (int a = 0; a < 4; ++a) { own[a] = (p[kt][4 * a] + p[kt][4 * a + 1]) + (p[kt][4 * a + 2] + p[kt][4 * a + 3]); rcv[a] = swap_other(p[kt][4 * a + 3], hi); }
#pragma unroll
                for (int a = 0; a < 4; ++a) { const float inc = hi ? rcv[a] : (a == 0 ? carry : rcv[a > 0 ? a - 1 : 0]); tot[a] = own[a] + inc; tot[a] += __shfl_xor(tot[a], 1); tot[a] += __shfl_xor(tot[a], 2); }
                carry = rcv[3];
                if ((r32 & 3) == 0) {
#pragma unroll
                    for (int a = 0; a < 4; ++a) IMP[ql * 128 + 16 * i + 8 * kt + 2 * a + hi] = tot[a]; } }
            pv_tile<4>(o, p, Kt + 16384, lane);
            if (i + 1 < ntc) stage_write<4>(R, lds + ((i + 1) & 1) * 32768, lds + ((i + 1) & 1) * 32768 + 16384, tid, true);
            __syncthreads(); }
        { float gcc = gate_c; DBG_CHECK(0, gcc); }
#pragma unroll
        for (int dt = 0; dt < 4; ++dt)
#pragma unroll
            for (int a = 0; a < 4; ++a) { f32x4 r; r[0] = gate_c * o[dt][4 * a]; r[1] = gate_c * o[dt][4 * a + 1]; r[2] = gate_c * o[dt][4 * a + 2]; r[3] = gate_c * o[dt][4 * a + 3]; *(f32x4*)(ACC + 32 * dt + 8 * a) = r; }
    }
    for (int qi = 0; qi < 8; ++qi) { const int qq = 8 * w + qi; float e0, e1;
        { const int j = lane; const bool allowed = j <= blk, forced = (j == 0) || (j == blk) || (j == blk - 1); e0 = allowed ? IMP[qq * 128 + j] + (forced ? 1.0e4f : 0.f) : NEG_INF; }
        { const int j = lane + 64; const bool allowed = j <= blk, forced = (j == blk) || (j == blk - 1); e1 = allowed ? IMP[qq * 128 + j] + (forced ? 1.0e4f : 0.f) : NEG_INF; }
        EV[lane] = e0; EV[lane + 64] = e1;
        __syncthreads();
        int r0 = 0, r1 = 0;
        for (int i = 0; i <= blk; ++i) { const float x = EV[i]; r0 += (x > e0 || (x == e0 && i < lane)) ? 1 : 0; r1 += (x > e1 || (x == e1 && i < lane + 64)) ? 1 : 0; }
        const unsigned long long b0 = __ballot(r0 < 16), b1 = __ballot(r1 < 16);
        if (lane == 0) { SEL[qq * 4 + 0] = (unsigned)b0; SEL[qq * 4 + 1] = (unsigned)(b0 >> 32); SEL[qq * 4 + 2] = (unsigned)b1; SEL[qq * 4 + 3] = (unsigned)(b1 >> 32); }
        __syncthreads(); }
    if (tid < 4) { unsigned u = 0; for (int q = 0; q < 64; ++q) u |= SEL[q * 4 + tid]; UNI[tid] = u; }
    __syncthreads();
    unsigned selw[4], wun[4], uni[4];
#pragma unroll
    for (int k = 0; k < 4; ++k) { selw[k] = SEL[ql * 4 + k]; uni[k] = __builtin_amdgcn_readfirstlane(UNI[k]); unsigned x = selw[k];
#pragma unroll
        for (int o_ = 1; o_ < 64; o_ <<= 1) x |= __shfl_xor(x, o_);
        wun[k] = __builtin_amdgcn_readfirstlane(x); }
#define BIT(arr, j) (((j) < 32 ? arr[0] >> (j) : (j) < 64 ? arr[1] >> ((j) - 32) : (j) < 96 ? arr[2] >> ((j) - 64) : arr[3] >> ((j) - 96)) & 1u)
    {
        const bf16* Kg = (const bf16*)(ws + WS_KV + 2 * KV_SLOT) + (size_t)g * S * 128; const bf16* Vg = (const bf16*)(ws + WS_KV + 3 * KV_SLOT) + (size_t)g * S * 128;
        float m = NEG_INF, l = 0.f;
#pragma unroll
        for (int dt = 0; dt < 4; ++dt)
#pragma unroll
            for (int i = 0; i < 16; ++i) o[dt][i] = 0.f;
        int j = 0; while (j <= blk && !BIT(uni, j)) ++j;
        int cur = 0;
        if (j <= blk) { stage_load<4>(R, Kg, Vg, (size_t)j * 64, tid, true); stage_write<4>(R, lds, lds + 16384, tid, true); }
        __syncthreads();
        while (j <= blk) {
            int jn = j + 1; while (jn <= blk && !BIT(uni, jn)) ++jn;
            LAS unsigned char* Kt = lds + cur * 32768;
            if (jn <= blk) stage_load<4>(R, Kg, Vg, (size_t)jn * 64, tid, true);
            if (BIT(wun, j)) {
                qk_tile<4>(p, qf, Kt, r32, hi);
                const bool sel = BIT(selw, j) != 0u; const bool last = j == blk;
#pragma unroll
                for (int kt = 0; kt < 2; ++kt)
#pragma unroll
                    for (int e = 0; e < 16; ++e) if (!sel || (last && 32 * kt + crow(e, hi) > ql)) p[kt][e] = NEG_INF;
                online_update<4>(o, m, l, p, Kt + 16384, lane);
            }
            if (jn <= blk) stage_write<4>(R, lds + (cur ^ 1) * 32768, lds + (cur ^ 1) * 32768 + 16384, tid, true);
            __syncthreads(); cur ^= 1; j = jn; }
        l = swap_sum(l); float sc = gate_s / fmaxf(l, 1e-30f); DBG_CHECK(1, sc);
#pragma unroll
        for (int dt = 0; dt < 4; ++dt)
#pragma unroll
            for (int a = 0; a < 4; ++a) { f32x4 r = *(const f32x4*)(ACC + 32 * dt + 8 * a); r[0] += sc * o[dt][4 * a]; r[1] += sc * o[dt][4 * a + 1]; r[2] += sc * o[dt][4 * a + 2]; r[3] += sc * o[dt][4 * a + 3]; *(f32x4*)(ACC + 32 * dt + 8 * a) = r; }
    }
    {
        const bf16* Kg = (const bf16*)(ws + WS_KV + 4 * KV_SLOT) + (size_t)g * S * 128; const bf16* Vg = (const bf16*)(ws + WS_KV + 5 * KV_SLOT) + (size_t)g * S * 128;
        float m = NEG_INF, l = 0.f;
#pragma unroll
        for (int dt = 0; dt < 4; ++dt)
#pragma unroll
            for (int i = 0; i < 16; ++i) o[dt][i] = 0.f;
        const int j0 = blk >= 8 ? blk - 8 : 0;
        stage_load<4>(R, Kg, Vg, (size_t)j0 * 64, tid, true); stage_write<4>(R, lds, lds + 16384, tid, true); __syncthreads();
        for (int j = j0; j <= blk; ++j) { LAS unsigned char* Kt = lds + ((j - j0) & 1) * 32768;
            if (j + 1 <= blk) stage_load<4>(R, Kg, Vg, (size_t)(j + 1) * 64, tid, true);
            qk_tile<4>(p, qf, Kt, r32, hi);
            if (j == blk) {
#pragma unroll
                for (int kt = 0; kt < 2; ++kt)
#pragma unroll
                    for (int e = 0; e < 16; ++e) if (32 * kt + crow(e, hi) > ql) p[kt][e] = NEG_INF; }
            if (j == blk - 8) {
#pragma unroll
                for (int kt = 0; kt < 2; ++kt)
#pragma unroll
                    for (int e = 0; e < 16; ++e) if (32 * kt + crow(e, hi) <= ql) p[kt][e] = NEG_INF; }
            online_update<4>(o, m, l, p, Kt + 16384, lane);
            if (j + 1 <= blk) stage_write<4>(R, lds + ((j + 1 - j0) & 1) * 32768, lds + ((j + 1 - j0) & 1) * 32768 + 16384, tid, true);
            __syncthreads(); }
        l = swap_sum(l); float sc = gate_w / fmaxf(l, 1e-30f); DBG_CHECK(2, sc);
#pragma unroll
        for (int dt = 0; dt < 4; ++dt)
#pragma unroll
            for (int a = 0; a < 4; ++a) { const size_t off = (size_t)t * DM + head * 128 + 32 * dt + 8 * a + 4 * hi; const v2u z = *(const v2u*)(ZS + off); const f32x4 f = *(const f32x4*)(ACC + 32 * dt + 8 * a);
                f32x4 r; r[0] = (f[0] + sc * o[dt][4 * a]) * bflo(z.x); r[1] = (f[1] + sc * o[dt][4 * a + 1]) * bfhi(z.x); r[2] = (f[2] + sc * o[dt][4 * a + 2]) * bflo(z.y); r[3] = (f[3] + sc * o[dt][4 * a + 3]) * bfhi(z.y);
                *(v2u*)(HB + off) = pk4(r); }
    }
#undef BIT
    __syncthreads();
}

__device__ __forceinline__ void swa_attn_unit(const Ctx& C0, unsigned char* ws, int i32, int kvh, const float* __restrict__ sinks) {
    const Ctx C = fresh_ctx(C0);
    LAS unsigned char* lds = C.lds; const int tid = C.tid, lane = C.lane, w = C.wave, r32 = lane & 31, hi = lane >> 5;
    const int ql = 4 * w + (r32 >> 3), head = kvh * 8 + (r32 & 7), t = 32 * i32 + ql;
    const bf16* QB = (const bf16*)(ws + WS_QB); const bf16* ZS = (const bf16*)(ws + WS_ZS); bf16* HB = (bf16*)(ws + WS_HB);
    const bf16* Kg = (const bf16*)(ws + WS_KS) + (size_t)kvh * S * 64; const bf16* Vg = (const bf16*)(ws + WS_VS) + (size_t)kvh * S * 64;
    bf16x8 qf[4];
#pragma unroll
    for (int s = 0; s < 4; ++s) qf[s] = *(const bf16x8*)(QB + (size_t)t * DM + head * 64 + 16 * s + 8 * hi);
    f32x16 o[2], p[2];
#pragma unroll
    for (int dt = 0; dt < 2; ++dt)
#pragma unroll
        for (int i = 0; i < 16; ++i) o[dt][i] = 0.f;
    float m = NEG_INF, l = 0.f;
    const int klo = 32 * i32 - 127 > 0 ? 32 * i32 - 127 : 0, j0 = klo >> 6, j1 = (32 * i32 + 31) >> 6;
    StageRegs<2> R;
    stage_load<2>(R, Kg, Vg, (size_t)j0 * 64, tid, true); stage_write<2>(R, lds, lds + 8192, tid, true); __syncthreads();
    for (int j = j0; j <= j1; ++j) { LAS unsigned char* Kt = lds + ((j - j0) & 1) * 16384;
        if (j + 1 <= j1) stage_load<2>(R, Kg, Vg, (size_t)(j + 1) * 64, tid, true);
        qk_tile<2>(p, qf, Kt, r32, hi);
#pragma unroll
        for (int kt = 0; kt < 2; ++kt)
#pragma unroll
            for (int e = 0; e < 16; ++e) { const int key = 64 * j + 32 * kt + crow(e, hi); if (key > t || key < t - 127) p[kt][e] = NEG_INF; }
        online_update<2>(o, m, l, p, Kt + 8192, lane);
        if (j + 1 <= j1) stage_write<2>(R, lds + ((j + 1 - j0) & 1) * 16384, lds + ((j + 1 - j0) & 1) * 16384 + 8192, tid, true);
        __syncthreads(); }
    l = swap_sum(l) + __builtin_amdgcn_exp2f(sinks[head] * LOG2E - m);
    const float sc = 1.f / l;
#pragma unroll
    for (int dt = 0; dt < 2; ++dt)
#pragma unroll
        for (int a = 0; a < 4; ++a) { const size_t off = (size_t)t * DM + head * 64 + 32 * dt + 8 * a + 4 * hi; const v2u z = *(const v2u*)(ZS + off);
            f32x4 r; r[0] = o[dt][4 * a] * sc * bflo(z.x); r[1] = o[dt][4 * a + 1] * sc * bfhi(z.x); r[2] = o[dt][4 * a + 2] * sc * bflo(z.y); r[3] = o[dt][4 * a + 3] * sc * bfhi(z.y);
            *(v2u*)(HB + off) = pk4(r); }
}
#ifdef HYBRID
namespace nv {

constexpr int S = 8192, D = 2048;
constexpr float ALPHA = 1.681792830507429f;
constexpr float LN_EPS = 1e-5f, RMS_EPS = 1e-6f;
constexpr int HG_IN = 8192, NSA_IN = 7216, SWA_IN = 4608;

using ::RotC;

__device__ __forceinline__ float silu_f(float x) { return x / (1.f + expf(-x)); }
__device__ __forceinline__ float sigmoid_f(float x) { return 1.f / (1.f + expf(-x)); }

__global__ __launch_bounds__(256) void gemm_f32(const float* __restrict__ A, int lda, const float* __restrict__ B, int ldb, float* __restrict__ C, int ldc, int N, int K) {
    __shared__ float As[16][132];
    __shared__ float Bs[16][132];
    const int tid = threadIdx.x, bm = blockIdx.y * 128, bn = blockIdx.x * 128, tx = tid & 15, ty = tid >> 4;
    float acc[8][8];
#pragma unroll
    for (int i = 0; i < 8; ++i)
#pragma unroll
        for (int j = 0; j < 8; ++j) acc[i][j] = 0.f;
    for (int k0 = 0; k0 < K; k0 += 16) {
#pragma unroll
        for (int i = 0; i < 8; ++i) { const int idx = tid + 256 * i, r = idx >> 4, c = idx & 15; As[c][r] = A[(size_t)(bm + r) * lda + k0 + c]; }
#pragma unroll
        for (int i = 0; i < 8; ++i) { const int idx = tid + 256 * i, r = idx >> 7, c = idx & 127; Bs[r][c] = (bn + c < N) ? B[(size_t)(k0 + r) * ldb + bn + c] : 0.f; }
        __syncthreads();
#pragma unroll
        for (int kk = 0; kk < 16; ++kk) {
            float a[8], b[8];
#pragma unroll
            for (int i = 0; i < 8; ++i) a[i] = As[kk][ty * 8 + i];
#pragma unroll
            for (int j = 0; j < 8; ++j) b[j] = Bs[kk][tx * 8 + j];
#pragma unroll
            for (int i = 0; i < 8; ++i)
#pragma unroll
                for (int j = 0; j < 8; ++j) acc[i][j] = fmaf(a[i], b[j], acc[i][j]);
        }
        __syncthreads();
    }
#pragma unroll
    for (int i = 0; i < 8; ++i)
#pragma unroll
        for (int j = 0; j < 8; ++j) { const int c = bn + tx * 8 + j; if (c < N) C[(size_t)(bm + ty * 8 + i) * ldc + c] = acc[i][j]; }
}

__global__ void lb_kernel(const float* __restrict__ logits, float* __restrict__ lb1) {
    const int c = blockIdx.x * blockDim.x + threadIdx.x; if (c >= D) return;
    const float a = logits[c], b = logits[D + c], m = fmaxf(a, b), ea = expf(a - m), eb = expf(b - m), s = ea + eb;
    const float p0 = ea / s, p1 = eb / s; lb1[c] = (p0 + p1) - p0;
}
__global__ void hg_prep(float* __restrict__ proj, const float* __restrict__ lb) {
    const size_t idx = (size_t)blockIdx.x * blockDim.x + threadIdx.x; const int t = (int)(idx / D), c = (int)(idx % D);
    float* p = proj + (size_t)t * HG_IN + 2048 + c; const float l = lb ? lb[c] : 0.f; *p = l + (1.f - l) * sigmoid_f(*p);
}
__global__ __launch_bounds__(64) void hg_scan(float* __restrict__ proj) {
    const int j = blockIdx.x, h = blockIdx.y, lane = threadIdx.x, vi = lane & 15, kg = lane >> 4;
    float s[32];
#pragma unroll
    for (int i = 0; i < 32; ++i) s[i] = 0.f;
    for (int t = 0; t < S; ++t) {
        float* row = proj + (size_t)t * HG_IN;
        const float v = row[4096 + h * 128 + j * 16 + vi];
        float part = 0.f;
#pragma unroll
        for (int i = 0; i < 32; ++i) { const int k = h * 128 + kg * 32 + i; const float q = row[k], f = row[2048 + k]; s[i] = fmaf(f, s[i], (1.f - f) * v); part = fmaf(q, s[i], part); }
        part += __shfl_xor(part, 16); part += __shfl_xor(part, 32);
        if (kg == 0) row[4096 + h * 128 + j * 16 + vi] = part;
    }
}
__global__ __launch_bounds__(256) void hg_norm(float* __restrict__ proj, const float* __restrict__ gn) {
    const int t = blockIdx.x, tid = threadIdx.x; float* row = proj + (size_t)t * HG_IN;
    float o[8], ss = 0.f;
#pragma unroll
    for (int i = 0; i < 8; ++i) { o[i] = row[4096 + tid * 8 + i]; ss += o[i] * o[i]; }
    ss += __shfl_xor(ss, 1); ss += __shfl_xor(ss, 2); ss += __shfl_xor(ss, 4); ss += __shfl_xor(ss, 8);
    const float r = rsqrtf(ss * (1.f / 128.f) + RMS_EPS);
#pragma unroll
    for (int i = 0; i < 8; ++i) { const int c = tid * 8 + i; row[c] = o[i] * r * gn[c] * silu_f(row[6144 + c]); }
}
__global__ __launch_bounds__(256) void res_ln(const float* hin, const float* __restrict__ y, const float* __restrict__ g, const float* __restrict__ b, float* hout) {
    __shared__ float red[8];
    const int t = blockIdx.x, tid = threadIdx.x; float u[8], s = 0.f;
#pragma unroll
    for (int i = 0; i < 8; ++i) { const size_t o = (size_t)t * D + tid * 8 + i; u[i] = ALPHA * hin[o] + y[o]; s += u[i]; }
    for (int o = 1; o < 64; o <<= 1) s += __shfl_xor(s, o);
    if ((tid & 63) == 0) red[tid >> 6] = s; __syncthreads();
    const float mean = (red[0] + red[1] + red[2] + red[3]) * (1.f / D); __syncthreads();
    float q = 0.f;
#pragma unroll
    for (int i = 0; i < 8; ++i) { u[i] -= mean; q += u[i] * u[i]; }
    for (int o = 1; o < 64; o <<= 1) q += __shfl_xor(q, o);
    if ((tid & 63) == 0) red[tid >> 6] = q; __syncthreads();
    const float rstd = rsqrtf((red[0] + red[1] + red[2] + red[3]) * (1.f / D) + LN_EPS);
#pragma unroll
    for (int i = 0; i < 8; ++i) { const int c = tid * 8 + i; hout[(size_t)t * D + c] = u[i] * rstd * g[c] + b[c]; }
}
__global__ void rot_tab(const int* __restrict__ pos, float2* __restrict__ tn, float2* __restrict__ tw, RotC rc) {
    const int idx = blockIdx.x * blockDim.x + threadIdx.x; if (idx >= S * 24) return;
    const int t = idx / 24, i = idx % 24; const double f = i < 16 ? rc.nsa[i] : rc.swa[i - 16];
    double r = (double)pos[t] * f; r -= floor(r); const float a = (float)(r * 6.283185307179586);
    const float2 cs = make_float2(cosf(a), sinf(a));
    if (i < 16) tn[t * 16 + i] = cs; else tw[t * 8 + (i - 16)] = cs;
}
__global__ void nsa_rot(float* __restrict__ proj, const float2* __restrict__ tn) {
    const int idx = blockIdx.x * blockDim.x + threadIdx.x; if (idx >= S * 28 * 16) return;
    const int i = idx & 15, slot = (idx >> 4) % 28, t = idx / (28 * 16);
    const int base = slot < 16 ? slot * 128 : slot < 20 ? 2048 + (slot - 16) * 128 : slot < 24 ? 3072 + (slot - 20) * 128 : 4096 + (slot - 24) * 128;
    float* p = proj + (size_t)t * NSA_IN + base; const float2 cs = tn[t * 16 + i]; const float x1 = p[i], x2 = p[16 + i];
    p[i] = x1 * cs.x - x2 * cs.y; p[16 + i] = x2 * cs.x + x1 * cs.y;
}
__global__ void swa_rot(float* __restrict__ proj, const float2* __restrict__ tw) {
    const int idx = blockIdx.x * blockDim.x + threadIdx.x; if (idx >= S * 36 * 8) return;
    const int i = idx & 7, slot = (idx >> 3) % 36, t = idx / (36 * 8);
    const int base = slot < 32 ? slot * 64 : 2048 + (slot - 32) * 64;
    float* p = proj + (size_t)t * SWA_IN + base; const float2 cs = tw[t * 8 + i]; const float x1 = p[i], x2 = p[8 + i];
    p[i] = x1 * cs.x - x2 * cs.y; p[8 + i] = x2 * cs.x + x1 * cs.y;
}
__global__ __launch_bounds__(256) void nsa_cmp(const float* __restrict__ proj, const float* __restrict__ posk, const float* __restrict__ w1k, const float* __restrict__ w2k,
                                               const float* __restrict__ posv, const float* __restrict__ w1v, const float* __restrict__ w2v, float* __restrict__ cb) {
    __shared__ float flat[4096]; __shared__ float hid[256];
    const int i = blockIdx.x, g = blockIdx.y, which = blockIdx.z, tid = threadIdx.x;
    const float* pos = which ? posv : posk; const float* w1 = which ? w1v : w1k; const float* w2 = which ? w2v : w2k; const int col = which ? 2560 : 2048;
    for (int kk = tid; kk < 4096; kk += 256) flat[kk] = proj[(size_t)(16 * i + (kk >> 7)) * NSA_IN + col + g * 128 + (kk & 127)] + pos[kk];
    __syncthreads();
    float a = 0.f;
    for (int kk = 0; kk < 4096; ++kk) a = fmaf(flat[kk], w1[(size_t)kk * 256 + tid], a);
    hid[tid] = silu_f(a); __syncthreads();
    if (tid < 128) { float o = 0.f; for (int n = 0; n < 256; ++n) o = fmaf(hid[n], w2[n * 128 + tid], o); cb[((size_t)(which * 4 + g) * 512 + i) * 128 + tid] = o; }
}
__device__ __forceinline__ float dot128(const float* __restrict__ q, const float* __restrict__ k) {
    float a = 0.f;
#pragma unroll 8
    for (int d = 0; d < 128; d += 4) { const float4 kv = *(const float4*)(k + d); a = fmaf(q[d], kv.x, a); a = fmaf(q[d + 1], kv.y, a); a = fmaf(q[d + 2], kv.z, a); a = fmaf(q[d + 3], kv.w, a); }
    return a;
}
__device__ __forceinline__ float wave_max(float v) { for (int o = 1; o < 64; o <<= 1) v = fmaxf(v, __shfl_xor(v, o)); return v; }
__device__ __forceinline__ float wave_sum(float v) { for (int o = 1; o < 64; o <<= 1) v += __shfl_xor(v, o); return v; }
__global__ __launch_bounds__(256) void nsa_attn(float* __restrict__ proj, const float* __restrict__ cb) {
    __shared__ float qs[4][128]; __shared__ float pc[4][512]; __shared__ float ps[4][1024]; __shared__ float ev[128]; __shared__ int selflag[128];
    const int t = blockIdx.x, g = blockIdx.y, tid = threadIdx.x, r = tid >> 6, lane = tid & 63, h = 4 * g + r;
    const float scale = 0.08838834764831845f;
    float* row = proj + (size_t)t * NSA_IN;
    qs[r][lane] = row[h * 128 + lane]; qs[r][lane + 64] = row[h * 128 + lane + 64];
    __syncthreads();
    const float* q = qs[r];
    const float* kcb = cb + (size_t)(0 * 4 + g) * 512 * 128; const float* vcb = cb + (size_t)(1 * 4 + g) * 512 * 128;
    const int nvalid = t >= 31 ? (t - 31) / 16 + 1 : 0;
    float m = -INFINITY;
    for (int n = lane; n < 512; n += 64) { float s = -INFINITY; if (n < nvalid) s = scale * dot128(q, kcb + (size_t)n * 128); pc[r][n] = s; m = fmaxf(m, s); }
    m = wave_max(m); if (!(m > -INFINITY)) m = 0.f;
    float l = 0.f;
    for (int n = lane; n < 512; n += 64) { const float e = expf(pc[r][n] - m); pc[r][n] = e; l += e; }
    l = wave_sum(l); const float il = 1.f / fmaxf(l, 1e-30f);
    for (int n = lane; n < 512; n += 64) pc[r][n] *= il;
    float oc0 = 0.f, oc1 = 0.f;
    for (int n = 0; n < nvalid; ++n) { const float p = pc[r][n]; oc0 = fmaf(p, vcb[(size_t)n * 128 + lane], oc0); oc1 = fmaf(p, vcb[(size_t)n * 128 + lane + 64], oc1); }
    __syncthreads();
    const int cur = t >> 6;
    if (tid < 128) { const int j = tid; float imp = 0.f;
        for (int rr = 0; rr < 4; ++rr) for (int n = 4 * j - 1; n <= 4 * j + 3; ++n) if (n >= 0 && n <= 510) imp += pc[rr][n];
        const bool allowed = j * 64 <= t, forced = (j == 0) || (j == cur) || (j == cur - 1);
        ev[j] = allowed ? imp + (forced ? 1.0e4f : 0.f) : -INFINITY; }
    __syncthreads();
    if (tid < 128) { const int j = tid; const float e = ev[j]; int rank = 0;
        for (int i = 0; i < 128; ++i) { const float x = ev[i]; rank += (x > e || (x == e && i < j)) ? 1 : 0; }
        selflag[j] = rank < 16 ? 1 : 0; }
    __syncthreads();
    float os0 = 0.f, os1 = 0.f;
    { int ns = 0; float mm = -INFINITY;
      for (int j = 0; j <= cur; ++j) if (selflag[j]) { const int key = 64 * j + lane; float s = -INFINITY; if (key <= t) s = scale * dot128(q, proj + (size_t)key * NSA_IN + 3072 + g * 128); ps[r][ns * 64 + lane] = s; mm = fmaxf(mm, s); ++ns; }
      mm = wave_max(mm); if (!(mm > -INFINITY)) mm = 0.f; float ll = 0.f;
      for (int i = 0; i < ns; ++i) { const float e = expf(ps[r][i * 64 + lane] - mm); ps[r][i * 64 + lane] = e; ll += e; }
      ll = wave_sum(ll); const float ill = 1.f / fmaxf(ll, 1e-30f);
      ns = 0;
      for (int j = 0; j <= cur; ++j) if (selflag[j]) { for (int kk = 0; kk < 64; ++kk) { const int key = 64 * j + kk; if (key > t) break; const float p = ps[r][ns * 64 + kk]; const float* vr = proj + (size_t)key * NSA_IN + 3584 + g * 128; os0 = fmaf(p, vr[lane], os0); os1 = fmaf(p, vr[lane + 64], os1); } ++ns; }
      os0 *= ill; os1 *= ill; }
    float ow0 = 0.f, ow1 = 0.f;
    { const int k0 = t >= 511 ? t - 511 : 0, nk = t - k0 + 1; float mm = -INFINITY;
      for (int i = lane; i < nk; i += 64) { const float s = scale * dot128(q, proj + (size_t)(k0 + i) * NSA_IN + 4096 + g * 128); ps[r][i] = s; mm = fmaxf(mm, s); }
      mm = wave_max(mm); float ll = 0.f;
      for (int i = lane; i < nk; i += 64) { const float e = expf(ps[r][i] - mm); ps[r][i] = e; ll += e; }
      ll = wave_sum(ll); const float ill = 1.f / fmaxf(ll, 1e-30f);
      for (int i = 0; i < nk; ++i) { const float p = ps[r][i]; const float* vr = proj + (size_t)(k0 + i) * NSA_IN + 4608 + g * 128; ow0 = fmaf(p, vr[lane], ow0); ow1 = fmaf(p, vr[lane + 64], ow1); }
      ow0 *= ill; ow1 *= ill; }
    const float g0 = sigmoid_f(row[5120 + 0 * 16 + h]), g1 = sigmoid_f(row[5120 + 1 * 16 + h]), g2 = sigmoid_f(row[5120 + 2 * 16 + h]);
    const float z0 = row[5168 + h * 128 + lane], z1 = row[5168 + h * 128 + lane + 64];
    row[h * 128 + lane] = (g0 * oc0 + g1 * os0 + g2 * ow0) * silu_f(z0);
    row[h * 128 + lane + 64] = (g0 * oc1 + g1 * os1 + g2 * ow1) * silu_f(z1);
}
__global__ __launch_bounds__(64) void swa_attn(float* __restrict__ proj, const float* __restrict__ sinks) {
    __shared__ float qs[64]; __shared__ float pl[128];
    const int t = blockIdx.x, h = blockIdx.y, kv = h >> 3, lane = threadIdx.x;
    float* row = proj + (size_t)t * SWA_IN;
    qs[lane] = row[h * 64 + lane]; __syncthreads();
    const float sink = sinks[h]; float m = sink; float s2[2];
#pragma unroll
    for (int i = 0; i < 2; ++i) { const int key = t - 127 + lane + 64 * i; float s = -INFINITY;
        if (key >= 0) { const float* kr = proj + (size_t)key * SWA_IN + 2048 + kv * 64; float a = 0.f; for (int d = 0; d < 64; ++d) a = fmaf(qs[d], kr[d], a); s = a * 0.125f; }
        s2[i] = s; m = fmaxf(m, s); }
    m = wave_max(m);
    float l = 0.f;
#pragma unroll
    for (int i = 0; i < 2; ++i) { const float e = expf(s2[i] - m); pl[lane + 64 * i] = e; l += e; }
    l = wave_sum(l) + expf(sink - m); __syncthreads();
    float o = 0.f;
    for (int i = 0; i < 128; ++i) { const int key = t - 127 + i; if (key < 0) continue; o = fmaf(pl[i], proj[(size_t)key * SWA_IN + 2304 + kv * 64 + lane], o); }
    o /= l;
    __syncthreads();
    row[h * 64 + lane] = o * silu_f(row[2560 + h * 64 + lane]);
}

}

static void naive_layers(int l0, int l1, void* const* d_in, float* H, char* ws, hipStream_t stream, const RotC& rc) {
    constexpr int D = nv::D, HG_IN = nv::HG_IN, NSA_IN = nv::NSA_IN, SWA_IN = nv::SWA_IN;
    const size_t MiB = 1u << 20;
    auto F = [&](int i) { return (const float*)d_in[i]; };
    float* proj = (float*)ws; float* Y = (float*)(ws + 256 * MiB); float* lb1 = (float*)(ws + 320 * MiB); float2* tn = (float2*)(ws + 321 * MiB); float2* tw = (float2*)(ws + 323 * MiB); float* cb = (float*)(ws + 324 * MiB);
    if (l0 > l1) return;
    nv::lb_kernel<<<D / 256, 256, 0, stream>>>(F(2), lb1);
    nv::rot_tab<<<(S * 24 + 255) / 256, 256, 0, stream>>>((const int*)d_in[1], tn, tw, rc);
    (void)hipMemsetAsync(cb, 0, 2 * MiB, stream);
    const float* hin = l0 == 0 ? F(0) : H;
    for (int layer = l0; layer <= l1; ++layer) {
        if (layer == 0 || layer == 3) {
            const int b = layer == 0 ? 3 : 23;
            nv::gemm_f32<<<dim3(HG_IN / 128, S / 128), 256, 0, stream>>>(hin, D, F(b), HG_IN, proj, HG_IN, HG_IN, D);
            nv::hg_prep<<<S * D / 256, 256, 0, stream>>>(proj, layer == 0 ? nullptr : lb1);
            nv::hg_scan<<<dim3(8, 16), 64, 0, stream>>>(proj);
            nv::hg_norm<<<S, 256, 0, stream>>>(proj, F(b + 1));
            nv::gemm_f32<<<dim3(D / 128, S / 128), 256, 0, stream>>>(proj, HG_IN, F(b + 2), D, Y, D, D, D);
            nv::res_ln<<<S, 256, 0, stream>>>(hin, Y, F(b + 3), F(b + 4), H);
        } else if (layer == 1) {
            nv::gemm_f32<<<dim3((NSA_IN + 127) / 128, S / 128), 256, 0, stream>>>(hin, D, F(8), NSA_IN, proj, NSA_IN, NSA_IN, D);
            nv::nsa_rot<<<(S * 28 * 16 + 255) / 256, 256, 0, stream>>>(proj, tn);
            nv::nsa_cmp<<<dim3(511, 4, 2), 256, 0, stream>>>(proj, F(9), F(10), F(11), F(12), F(13), F(14), cb);
            nv::nsa_attn<<<dim3(S, 4), 256, 0, stream>>>(proj, cb);
            nv::gemm_f32<<<dim3(D / 128, S / 128), 256, 0, stream>>>(proj, NSA_IN, F(15), D, Y, D, D, D);
            nv::res_ln<<<S, 256, 0, stream>>>(hin, Y, F(16), F(17), H);
        } else {
            nv::gemm_f32<<<dim3(SWA_IN / 128, S / 128), 256, 0, stream>>>(hin, D, F(18), SWA_IN, proj, SWA_IN, SWA_IN, D);
            nv::swa_rot<<<(S * 36 * 8 + 255) / 256, 256, 0, stream>>>(proj, tw);
            nv::swa_attn<<<dim3(S, 32), 64, 0, stream>>>(proj, F(19));
            nv::gemm_f32<<<dim3(D / 128, S / 128), 256, 0, stream>>>(proj, SWA_IN, F(20), D, Y, D, D, D);
            nv::res_ln<<<S, 256, 0, stream>>>(hin, Y, F(21), F(22), H);
        }
        hin = H;
    }
}
#endif
#ifndef ONLY
#define ONLY -1
#endif
#define PHON(n) (ONLY < 0 || ONLY == (n))
template <int layer> __device__ __forceinline__ void run_layer(const Ctx& C, const Args& A, const XcdBarrier& bar) {
    const int bx = blockIdx.x, G = C.G; unsigned char* ws = A.ws; float* H = A.out;
    bf16* HB = (bf16*)(ws + WS_HB); bf16* WIN = (bf16*)(ws + WS_WIN); bf16* WOUT = (bf16*)(ws + WS_WOUT);
#define GRID_BAR() xcd_barrier(bar)

        constexpr int kind = layer == 3 ? 0 : layer;
        const float* hprev = layer == 0 ? (const float*)A.in[0] : H;
        constexpr int pb = layer == 0 ? 3 : layer == 1 ? 8 : layer == 2 ? 18 : 23;
        if (!(PHON(1) || ONLY >= 10)) {} else if (kind == 0 && (ONLY < 10 || ONLY == 10)) {
            pg8::Gemm g{HB, WIN, S, 8192, DM}; pg8::StaticOrder So; So.init(S, 8192, G, bx);
            pg8::EpiHG E{ws, layer == 0 ? nullptr : (const float*)(ws + WS_LB)};
            pg8::gemm_phase<pg8::EpiHG, pg8::StaticOrder, true, true>(C.lds, g, So, E);
        } else if (kind == 1 && (ONLY < 10 || ONLY == 11)) {
            pg8::Gemm g{HB, WIN, S, 7424, DM}; pg8::StaticOrder So; So.init(S, 7424, G, bx);
            pg8::EpiNSA E{ws};
            pg8::gemm_phase<pg8::EpiNSA, pg8::StaticOrder, true, true>(C.lds, g, So, E);
        } else if (kind == 2 && (ONLY < 10 || ONLY == 12)) {
            pg8::Gemm g{HB, WIN, S, 4608, DM}; pg8::StaticOrder So; So.init(S, 4608, G, bx);
            pg8::EpiSWA E{ws};
            pg8::gemm_phase<pg8::EpiSWA, pg8::StaticOrder, true, true>(C.lds, g, So, E);
        }
        GRID_BAR();
        if (kind == 0) {
            if (PHON(2)) for (int u = bx; u < 2048; u += G) hgx_unit(C, ws, u >> 4, u & 15);
            GRID_BAR();
            if (PHON(3)) if (bx < 16) hgr_head(C, ws, bx, (const float*)A.in[pb + 1]);
            GRID_BAR();
        } else if (kind == 1) {
            if (PHON(4)) for (int u = bx; u < 256; u += G) nsa_cmp_unit(C, ws, u);
            GRID_BAR();
            if (PHON(5)) for (int k = bx; k < 512; k += G) { const int pi = k & 255, second = k >> 8, g = pi & 3, b = pi >> 2; nsa_attn_unit(C, ws, second ? b : 127 - b, g); }
            GRID_BAR();
        } else {
            if (PHON(6)) for (int u = bx; u < 1024; u += G) { swa_attn_unit(C, ws, u >> 2, u & 3, (const float*)A.in[19]); __syncthreads(); }
            GRID_BAR();
        }
        if (PHON(7)) {
            const int wo = kind == 0 ? pb + 2 : kind == 1 ? 15 : 20; (void)wo;
            pg8::Gemm g{HB, WOUT, S, DM, DM}; pg8::StaticOrder So; So.init(S, DM, G, bx);
            pg8::EpiOut E{hprev, H};
            pg8::gemm_phase<pg8::EpiOut, pg8::StaticOrder, true, true>(C.lds, g, So, E);
        }
        GRID_BAR();
        {
            const int lg = kind == 0 ? pb + 3 : kind == 1 ? 16 : 21;
            if (PHON(8)) ln_phase(C, H, HB, (const float*)A.in[lg], (const float*)A.in[lg + 1], layer < MK_HI);
            if (layer < MK_HI) { if (PHON(9)) conv_layer(C, A, layer + 1); GRID_BAR(); }
        }

#undef GRID_BAR
}
__global__ void __launch_bounds__(NWAVES * 64, 2) mk_fwd(Args A) {
    extern __shared__ __attribute__((aligned(16))) unsigned char lds_raw[];
    Ctx C; C.lds = (LAS unsigned char*)lds_raw; C.tid = threadIdx.x; C.lane = C.tid & 63; C.wave = __builtin_amdgcn_readfirstlane(C.tid >> 6);
    C.G = gridDim.x; { const int bx = blockIdx.x; C.vcu = (C.G % 8 == 0) ? (bx % 8) * (C.G / 8) + bx / 8 : bx; }
    const int bx = blockIdx.x, G = C.G;
    unsigned char* ws = A.ws;
    gu32* ctl = (gu32*)(ws + WS_CTL);
    for (int u = C.tid; u < (LDS_BYTES - LDSCTL_OFF) / 4; u += NWAVES * 64) ((LAS unsigned*)(C.lds + LDSCTL_OFF))[u] = 0u;
    __syncthreads();
    const XcdBarrier bar = xcd_barrier_post((unsigned*)(ctl + CW_BAR), (volatile LAS unsigned*)(C.lds + MISC_OFF) + 8);
#define GRID_BAR() xcd_barrier(bar)

    if (PHON(0)) { conv_layer(C, A, MK_LO); p0_misc(C, A); }
    GRID_BAR();

    if (MK_LO <= 0 && 0 <= MK_HI) run_layer<0>(C, A, bar);
    if (MK_LO <= 1 && 1 <= MK_HI) run_layer<1>(C, A, bar);
    if (MK_LO <= 2 && 2 <= MK_HI) run_layer<2>(C, A, bar);
    if (MK_LO <= 3 && 3 <= MK_HI) run_layer<3>(C, A, bar);
#undef GRID_BAR
}

#ifdef DBG_NAN
__global__ void dbg_encode(const unsigned* cnt, float* out) { unsigned code = 1u + (cnt[0] ? 1u : 0u) + (cnt[1] ? 2u : 0u) + (cnt[2] ? 4u : 0u); out[0] += sqrtf((float)code) * 12961.f; }
#endif
extern "C" void kernel_launch(void* const* d_in, const int* in_sizes, int n_in, void* d_out, int out_size, void* d_ws, size_t ws_size, hipStream_t stream) {
    static int grid = 0;
    if (grid == 0) {
        if (n_in != 28 || out_size != S * DM || ws_size < WS_END) { fprintf(stderr, "kernel_launch: unexpected n_in %d / out_size %d / ws_size %zu (need %zu)\n", n_in, out_size, ws_size, (size_t)WS_END); grid = -1; return; }
        int dev = 0, cus = 0, per_cu = 0;
        if (hipGetDevice(&dev) != hipSuccess || hipDeviceGetAttribute(&cus, hipDeviceAttributeMultiprocessorCount, dev) != hipSuccess) { grid = -1; return; }
        if (hipFuncSetAttribute((const void*)mk_fwd, hipFuncAttributeMaxDynamicSharedMemorySize, LDS_BYTES) != hipSuccess) { fprintf(stderr, "kernel_launch: hipFuncSetAttribute failed\n"); grid = -1; return; }
        if (hipOccupancyMaxActiveBlocksPerMultiprocessor(&per_cu, (const void*)mk_fwd, NWAVES * 64, LDS_BYTES) != hipSuccess || per_cu < 1) { fprintf(stderr, "kernel_launch: occupancy query reports %d blocks per CU\n", per_cu); per_cu = 1; }
        (void)hipGetLastError();
        grid = cus;
    }
    if (grid < 0) return;
    RotC rc0{};
    for (int i = 0; i < 16; ++i) rc0.nsa[i] = std::pow(500000.0, -(double)(2 * i) / 32.0) / 6.283185307179586;
    for (int i = 0; i < 8; ++i) rc0.swa[i] = std::pow(500000.0, -(double)(2 * i) / 16.0) / 6.283185307179586;
#ifdef HYBRID
    naive_layers(0, MK_LO - 1, d_in, (float*)d_out, (char*)d_ws, stream, rc0);
#endif
    (void)hipMemsetAsync((char*)d_ws + WS_CTL, 0, CTL_ZERO_BYTES, stream);
    Args a{};
    for (int i = 0; i < 28; ++i) a.in[i] = d_in[i];
    a.out = (float*)d_out; a.ws = (unsigned char*)d_ws;
    for (int i = 0; i < 16; ++i) a.rc.nsa[i] = std::pow(500000.0, -(double)(2 * i) / 32.0) / 6.283185307179586;
    for (int i = 0; i < 8; ++i) a.rc.swa[i] = std::pow(500000.0, -(double)(2 * i) / 16.0) / 6.283185307179586;
    void* kargs[] = {&a};
    hipError_t e = hipLaunchCooperativeKernel((const void*)mk_fwd, dim3(grid), dim3(NWAVES * 64), kargs, LDS_BYTES, stream);
    if (e != hipSuccess) { (void)hipGetLastError(); fprintf(stderr, "kernel_launch: cooperative launch failed (%s); plain launch of the same resident grid\n", hipGetErrorString(e));
        hipLaunchKernelGGL(mk_fwd, dim3(grid), dim3(NWAVES * 64), LDS_BYTES, stream, a); }
#ifdef DBG_NAN
    dbg_encode<<<1, 1, 0, stream>>>((const unsigned*)((char*)d_ws + WS_CTL) + 8192, (float*)d_out);
#endif
#ifdef HYBRID
    naive_layers(MK_HI + 1, 3, d_in, (float*)d_out, (char*)d_ws, stream, rc0);
#endif
}
```

```cpp
#include <hip/hip_runtime.h>
#include <cstdio>
#include <cstdint>
#include <cmath>
#define GAS __attribute__((address_space(1)))
#define LAS __attribute__((address_space(3)))
typedef unsigned short bf16;
typedef unsigned v4u __attribute__((ext_vector_type(4)));
typedef unsigned v2u __attribute__((ext_vector_type(2)));
typedef float f32x4 __attribute__((ext_vector_type(4)));
typedef float f32x16 __attribute__((ext_vector_type(16)));
typedef short bf16x8 __attribute__((ext_vector_type(8)));
typedef short s16x4 __attribute__((ext_vector_type(4)));
typedef GAS unsigned gu32;
#define RLX_AGENT __ATOMIC_RELAXED, __HIP_MEMORY_SCOPE_AGENT
#define LDS_WAIT() asm volatile("s_waitcnt lgkmcnt(0)" ::: "memory")
typedef float f32x2_t __attribute__((ext_vector_type(2)));
typedef __bf16 bf16x2_t __attribute__((ext_vector_type(2)));
typedef unsigned u32x2 __attribute__((ext_vector_type(2)));
__device__ __forceinline__ unsigned pkbf(float lo, float hi) { f32x2_t v = {lo, hi}; bf16x2_t b = __builtin_convertvector(v, bf16x2_t); return __builtin_bit_cast(unsigned, b); }
__device__ __forceinline__ u32x2 pk4(f32x4 v) { u32x2 r; r.x = pkbf(v[0], v[1]); r.y = pkbf(v[2], v[3]); return r; }
__device__ __forceinline__ float fsilu(float x) { return x / (1.f + __expf(-x)); }
__device__ __forceinline__ float fsigm(float x) { return 1.f / (1.f + __expf(-x)); }
__device__ __forceinline__ float bf2f(unsigned short x) { return __uint_as_float((unsigned)x << 16); }
__device__ __forceinline__ float bflo(unsigned x) { return __uint_as_float(x << 16); }
__device__ __forceinline__ float bfhi(unsigned x) { return __uint_as_float(x & 0xffff0000u); }
__device__ __forceinline__ f32x4 mfma16(bf16x8 a, bf16x8 b, f32x4 c) { return __builtin_amdgcn_mfma_f32_16x16x32_bf16(a, b, c, 0, 0, 0); }
__device__ __forceinline__ f32x16 mfma32(bf16x8 a, bf16x8 b, f32x16 c) { return __builtin_amdgcn_mfma_f32_32x32x16_bf16(a, b, c, 0, 0, 0); }
typedef short v4i16_t __attribute__((ext_vector_type(4)));
__device__ __forceinline__ s16x4 tr_rd(const LAS unsigned char* p) { return __builtin_bit_cast(s16x4, __builtin_amdgcn_ds_read_tr16_b64_v4i16((LAS v4i16_t*)p)); }
__device__ __forceinline__ bf16x8 ld_frag(const LAS unsigned char* p) { return *(const LAS bf16x8*)p; }
__device__ __forceinline__ int crow(int r, int hi) { return (r & 3) + 8 * (r >> 2) + 4 * hi; }
__device__ __forceinline__ float swap_max(float m) { auto rr = __builtin_amdgcn_permlane32_swap(__float_as_uint(m), __float_as_uint(m), false, false); return fmaxf(__uint_as_float(rr[0]), __uint_as_float(rr[1])); }
__device__ __forceinline__ float swap_sum(float m) { auto rr = __builtin_amdgcn_permlane32_swap(__float_as_uint(m), __float_as_uint(m), false, false); return __uint_as_float(rr[0]) + __uint_as_float(rr[1]); }
__device__ __forceinline__ float swap_other(float m, int hi) { auto rr = __builtin_amdgcn_permlane32_swap(__float_as_uint(m), __float_as_uint(m), false, false); return hi ? __uint_as_float(rr[0]) : __uint_as_float(rr[1]); }

constexpr int S = 8192, DM = 2048, NWAVES = 8;
constexpr float ALPHA = 1.681792830507429f, LN_EPS = 1e-5f, RMS_EPS = 1e-6f, LOG2E = 1.4426950408889634f;
constexpr float QS_NSA = 0.08838834764831845f * LOG2E, QS_SWA = 0.125f * LOG2E;
constexpr float NEG_INF = -INFINITY;

constexpr size_t MiB = 1u << 20;
constexpr size_t WS_CTL = 0, CTL_ZERO_BYTES = 1 * MiB;
constexpr size_t WS_COSN = 1 * MiB, WS_SINN = WS_COSN + 512 * 1024, WS_COSW = 2 * MiB, WS_SINW = WS_COSW + 256 * 1024, WS_LB = WS_COSW + 512 * 1024, WS_C1P = 3 * MiB;
constexpr size_t WS_WIN = 4 * MiB, WS_W1TK = WS_WIN + 29 * MiB, WS_W1TV = WS_WIN + 31 * MiB, WS_W2TK = WS_WIN + 33 * MiB, WS_W2TV = WS_W2TK + 65536;
constexpr size_t WS_WOUT = 38 * MiB, WS_HB = 46 * MiB, WS_QB = 78 * MiB;
constexpr size_t WS_GB = 110 * MiB, WS_VB = 174 * MiB, WS_ZS = 206 * MiB, WS_AM = 238 * MiB, WS_UT = 254 * MiB, WS_ACC = 254 * MiB  , WS_DD = 318 * MiB, WS_END = 319 * MiB;
constexpr size_t WS_KV = 110 * MiB, KV_SLOT = 9 * MiB  , WS_GATE = 164 * MiB, WS_CB = 166 * MiB;
constexpr size_t WS_KS = 110 * MiB, WS_VS = 114 * MiB;
constexpr int CW_BAR = 4096;

constexpr int RING_BYTES = 131072, LDSCTL_OFF = RING_BYTES, MISC_OFF = LDSCTL_OFF + 320, LDS_BYTES = 147456;
namespace pg8 {
#define PG8_LAS __attribute__((address_space(3)))
typedef unsigned short bf16_t;
typedef short bf16x8 __attribute__((ext_vector_type(8)));
typedef float f32x4 __attribute__((ext_vector_type(4)));
typedef unsigned u32x4 __attribute__((ext_vector_type(4)));
constexpr int BM = 256, BK = 64, HALF = 128, HTB = HALF * BK * 2  , STAGE_BYTES = 8 * HTB, NXCD = 8, WGM = 8;

__host__ __device__ __forceinline__ int lds_byte(int r, int c) { const int st = (r >> 4) * 2 + (c >> 5), rr = r & 15, cc = c & 31, ob = rr * 64 + cc * 2; return st * 1024 + (ob ^ (((ob >> 9) & 1) << 5)); }
__host__ __device__ __forceinline__ void stage_rc(int b, int& R, int& C) { const int st = b / 1024, sb = b % 1024, swz = sb ^ (((sb >> 9) & 1) << 5); R = (st >> 1) * 16 + swz / 64; C = (st & 1) * 32 + (swz % 64) / 2; }
__host__ __device__ __forceinline__ int perm32(int rho) { const int n = rho >> 4, i = rho & 15; return 8 * (i >> 2) + 4 * n + (i & 3); }

struct Unit { int pm, pn; };
struct Gemm { const bf16_t* A; const bf16_t* Bt; int M, N, K; };

struct StaticOrder {
    int nM, nN, nwg, G, c;
    __host__ __device__ void init(int M, int N, int G_, int c_) { nM = M / BM; nN = N / BM; nwg = nM * nN; G = G_; c = c_; }
    __host__ __device__ bool next(int i, Unit& u) const {
        const long L = (long)i * G + c; if (L >= nwg) return false;
        int wgid = (int)L; { const int q = nwg / NXCD, r = nwg % NXCD, xcd = wgid % NXCD, off = wgid / NXCD; wgid = (xcd < r ? xcd * (q + 1) : r * (q + 1) + (xcd - r) * q) + off; }
        const int nig = WGM * nN, gid = wgid / nig, fm = gid * WGM, gsz = (nM - fm) < WGM ? (nM - fm) : WGM;
        u.pm = fm + ((wgid % nig) % gsz); u.pn = (wgid % nig) / gsz; return true;
    }
    __device__ __forceinline__ void a_ready(const Unit&) const {}
    __device__ __forceinline__ void done(const Unit&) const {}
};

constexpr int SEQ = 8192, DMODEL = 2048;
#define EPI_FENCE() asm volatile("" ::: "memory")
struct EpiHG {
    static constexpr bool PERM = false, AFTER_DRAIN = false;
    unsigned char* ws; const float* lb;
    __device__ __forceinline__ void operator()(const f32x4 (&acc)[2][2][4][2], const Unit& u, int wr, int wc, int fr, int fq) const {
        const int region = u.pn >> 3, cb = (u.pn & 7) * 256 + wc * 32 + 4 * fq, row0 = u.pm * BM + wr * 64 + fr;
        bf16_t* Q = (bf16_t*)(ws + WS_QB); float* G = (float*)(ws + WS_GB); bf16_t* V = (bf16_t*)(ws + WS_VB); bf16_t* Z = (bf16_t*)(ws + WS_ZS);
#pragma unroll
        for (int ai = 0; ai < 2; ++ai)
#pragma unroll
            for (int m = 0; m < 4; ++m) { const size_t ro = (size_t)(row0 + ai * HALF + m * 16) * DMODEL;
#pragma unroll
                for (int bj = 0; bj < 2; ++bj)
#pragma unroll
                    for (int n = 0; n < 2; ++n) { const int c = cb + bj * HALF + n * 16; const f32x4 v = acc[ai][bj][m][n];
                        if (region == 0) *(u32x2*)(Q + ro + c) = pk4(v);
                        else if (region == 2) *(u32x2*)(V + ro + c) = pk4(v);
                        else if (region == 3) { f32x4 z; z[0] = fsilu(v[0]); z[1] = fsilu(v[1]); z[2] = fsilu(v[2]); z[3] = fsilu(v[3]); *(u32x2*)(Z + ro + c) = pk4(z); }
                        else { f32x4 g;
                            if (lb) { const f32x4 l = *(const f32x4*)(lb + c);
#pragma unroll
                                for (int e = 0; e < 4; ++e) g[e] = __logf(l[e] + (1.f - l[e]) * fsigm(v[e])); }
                            else {
#pragma unroll
                                for (int e = 0; e < 4; ++e) g[e] = fminf(v[e], 0.f) - __logf(1.f + __expf(-fabsf(v[e]))); }
                            *(f32x4*)(G + ro + c) = g; } }
                EPI_FENCE(); }
    }
};
struct EpiNSA {
    static constexpr bool PERM = false, AFTER_DRAIN = false;
    unsigned char* ws;
    __device__ __forceinline__ void operator()(const f32x4 (&acc)[2][2][4][2], const Unit& u, int wr, int wc, int fr, int fq) const {
        const int pn = u.pn, row0 = u.pm * BM + wr * 64 + fr;
        bf16_t* Q = (bf16_t*)(ws + WS_QB); bf16_t* KV = (bf16_t*)(ws + WS_KV); bf16_t* Z = (bf16_t*)(ws + WS_ZS); float* GATE = (float*)(ws + WS_GATE);
        const float* cosT = (const float*)(ws + WS_COSN); const float* sinT = (const float*)(ws + WS_SINN);
#pragma unroll
        for (int ai = 0; ai < 2; ++ai)
#pragma unroll
            for (int m = 0; m < 4; ++m) { const int r = row0 + ai * HALF + m * 16;
#pragma unroll
                for (int bj = 0; bj < 2; ++bj) {
                    f32x4 v0 = acc[ai][bj][m][0], v1 = acc[ai][bj][m][1];
                    if (pn < 20) {
                        int slot = 0, g = 0; const bool isq = pn < 8;
                        if (!isq) { slot = (pn - 8) >> 1; g = ((pn - 8) & 1) * 2 + bj; }
                        if ((isq || !(slot & 1)) && wc == 0) {
                            const f32x4 cs = *(const f32x4*)(cosT + (size_t)r * 16 + 4 * fq), sn = *(const f32x4*)(sinT + (size_t)r * 16 + 4 * fq);
                            const f32x4 a = v0 * cs - v1 * sn, b = v1 * cs + v0 * sn; v0 = a; v1 = b; }
                        const int d = wc * 32 + 4 * fq;
                        if (isq) { bf16_t* p = Q + (size_t)r * DMODEL + pn * 256 + bj * HALF + d; *(u32x2*)p = pk4(v0 * QS_NSA); *(u32x2*)(p + 16) = pk4(v1 * QS_NSA); }
                        else { bf16_t* p = KV + (size_t)slot * (KV_SLOT / 2) + ((size_t)g * SEQ + r) * 128 + d; *(u32x2*)p = pk4(v0); *(u32x2*)(p + 16) = pk4(v1); }
                    } else if (pn < 28) {
                        bf16_t* p = Z + (size_t)r * DMODEL + (pn - 20) * 256 + bj * HALF + wc * 32 + 4 * fq;
                        f32x4 z0, z1;
#pragma unroll
                        for (int e = 0; e < 4; ++e) { z0[e] = fsilu(v0[e]); z1[e] = fsilu(v1[e]); }
                        *(u32x2*)p = pk4(z0); *(u32x2*)(p + 16) = pk4(z1);
                    } else if (bj == 0 && wc < 2) {
                        float* p = GATE + (size_t)r * 48 + wc * 32 + 4 * fq;
                        f32x4 s0, s1;
#pragma unroll
                        for (int e = 0; e < 4; ++e) { s0[e] = fsigm(v0[e]); s1[e] = fsigm(v1[e]); }
                        *(f32x4*)p = s0; if (wc == 0) *(f32x4*)(p + 16) = s1;
                    } }
                EPI_FENCE(); }
    }
};
struct EpiSWA {
    static constexpr bool PERM = false, AFTER_DRAIN = false;
    unsigned char* ws;
    __device__ __forceinline__ void operator()(const f32x4 (&acc)[2][2][4][2], const Unit& u, int wr, int wc, int fr, int fq) const {
        const int pn = u.pn, row0 = u.pm * BM + wr * 64 + fr;
        bf16_t* Q = (bf16_t*)(ws + WS_QB); bf16_t* KS = (bf16_t*)(ws + WS_KS); bf16_t* VS = (bf16_t*)(ws + WS_VS); bf16_t* Z = (bf16_t*)(ws + WS_ZS);
        const float* cosT = (const float*)(ws + WS_COSW); const float* sinT = (const float*)(ws + WS_SINW);
#pragma unroll
        for (int ai = 0; ai < 2; ++ai)
#pragma unroll
            for (int m = 0; m < 4; ++m) { const int r = row0 + ai * HALF + m * 16;
#pragma unroll
                for (int bj = 0; bj < 2; ++bj) {
                    f32x4 v0 = acc[ai][bj][m][0], v1 = acc[ai][bj][m][1];
                    if (pn < 9) {
                        if ((wc & 1) == 0) {
                            f32x4 xp;
#pragma unroll
                            for (int e = 0; e < 4; ++e) xp[e] = __shfl_xor(v0[e], 32);
                            const f32x4 cs = *(const f32x4*)(cosT + (size_t)r * 8 + 4 * (fq & 1)), sn = *(const f32x4*)(sinT + (size_t)r * 8 + 4 * (fq & 1));
                            v0 = (fq < 2) ? (v0 * cs - xp * sn) : (v0 * cs + xp * sn); }
                        if (pn < 8) { bf16_t* p = Q + (size_t)r * DMODEL + pn * 256 + bj * HALF + wc * 32 + 4 * fq; *(u32x2*)p = pk4(v0 * QS_SWA); *(u32x2*)(p + 16) = pk4(v1 * QS_SWA); }
                        else { const int kvh = bj * 2 + (wc >> 1), d = (wc & 1) * 32 + 4 * fq; bf16_t* p = KS + ((size_t)kvh * SEQ + r) * 64 + d; *(u32x2*)p = pk4(v0); *(u32x2*)(p + 16) = pk4(v1); }
                    } else if (pn == 9) {
                        const int kvh = bj * 2 + (wc >> 1), d = (wc & 1) * 32 + 4 * fq; bf16_t* p = VS + ((size_t)kvh * SEQ + r) * 64 + d; *(u32x2*)p = pk4(v0); *(u32x2*)(p + 16) = pk4(v1);
                    } else {
                        bf16_t* p = Z + (size_t)r * DMODEL + (pn - 10) * 256 + bj * HALF + wc * 32 + 4 * fq;
                        f32x4 z0, z1;
#pragma unroll
                        for (int e = 0; e < 4; ++e) { z0[e] = fsilu(v0[e]); z1[e] = fsilu(v1[e]); }
                        *(u32x2*)p = pk4(z0); *(u32x2*)(p + 16) = pk4(z1);
                    } }
                EPI_FENCE(); }
    }
};
struct EpiOut {
    static constexpr bool PERM = false, AFTER_DRAIN = false;
    const float* hprev; float* U;
    __device__ __forceinline__ void operator()(const f32x4 (&acc)[2][2][4][2], const Unit& u, int wr, int wc, int fr, int fq) const {
        const int row0 = u.pm * BM + wr * 64 + fr, cb = u.pn * BM + wc * 32 + 4 * fq;
#pragma unroll
        for (int ai = 0; ai < 2; ++ai)
#pragma unroll
            for (int m = 0; m < 4; ++m) { const size_t ro = (size_t)(row0 + ai * HALF + m * 16) * DMODEL;
#pragma unroll
                for (int bj = 0; bj < 2; ++bj)
#pragma unroll
                    for (int n = 0; n < 2; ++n) { const size_t o = ro + cb + bj * HALF + n * 16; const f32x4 hv = *(const f32x4*)(hprev + o); *(f32x4*)(U + o) = hv * ALPHA + acc[ai][bj][m][n]; }
                if (m & 1) EPI_FENCE(); }
    }
};
template <class Epi, class Sched, bool ALIGN_EPI = false, bool SP2 = false>
__device__ __forceinline__ void gemm_phase(PG8_LAS unsigned char* lds, const Gemm g, const Sched& S, const Epi& E) {
    int tid_ = threadIdx.x; asm volatile("" : "+v"(tid_));
    const int tid = tid_, wid = __builtin_amdgcn_readfirstlane(tid >> 6), lane = tid & 63, wr = wid >> 2, wc = wid & 3, fr = lane & 15, fq = lane >> 4;
    const int K = g.K, nt = K / BK;
    unsigned voffA[2], voffB[2];
#pragma unroll
    for (int i = 0; i < 2; ++i) { int R, C; stage_rc(tid * 16 + i * 8192, R, C); const int Rb = Epi::PERM ? ((R & ~31) + perm32(R & 31)) : R;
        voffA[i] = (unsigned)(R * K + C) * 2u; voffB[i] = (unsigned)(Rb * K + C) * 2u; }
    const size_t kstep = (size_t)(BK * 2);
    const size_t hstep = (size_t)HALF * K * 2;
    const size_t tstep = 2 * hstep;
    const unsigned ldsw = (unsigned)wid * 1024u;
    const int aoff = lds_byte(wr * 64 + fr, fq * 8), boff = lds_byte(wc * 32 + fr, fq * 8);
#define PG8_SA(b, h) (((b) * 2 + (h)) * HTB)
#define PG8_SB(b, h) ((4 + (b) * 2 + (h)) * HTB)
#define PG8_STAGE(bufoff, gbase, voff) do { _Pragma("unroll") for (int _i = 0; _i < 2; ++_i) \
        __builtin_amdgcn_global_load_lds((const unsigned*)((const char*)(gbase) + (voff)[_i]), (PG8_LAS unsigned*)(lds + (bufoff) + ldsw + _i * 8192), 16, 0, 0); } while (0)
#define PG8_LDA(dst, b, h) do { _Pragma("unroll") for (int m = 0; m < 4; ++m) _Pragma("unroll") for (int k = 0; k < 2; ++k) dst[m][k] = *(const PG8_LAS bf16x8*)(lds + PG8_SA(b, h) + aoff + m * 2048 + k * 1024); } while (0)
#define PG8_LDB(dst, b, h) do { _Pragma("unroll") for (int n = 0; n < 2; ++n) _Pragma("unroll") for (int k = 0; k < 2; ++k) dst[n][k] = *(const PG8_LAS bf16x8*)(lds + PG8_SB(b, h) + boff + n * 2048 + k * 1024); } while (0)
#define PG8_MMA(ai, bj, At, Bt) do { __builtin_amdgcn_s_setprio(1); _Pragma("unroll") for (int m = 0; m < 4; ++m) _Pragma("unroll") for (int n = 0; n < 2; ++n) _Pragma("unroll") for (int k = 0; k < 2; ++k) \
        acc[ai][bj][m][n] = __builtin_amdgcn_mfma_f32_16x16x32_bf16(Bt[n][k], At[m][k], acc[ai][bj][m][n], 0, 0, 0); __builtin_amdgcn_s_setprio(0); } while (0)
#define PG8_WAIT_V(n) asm volatile("s_waitcnt vmcnt(" #n ")" ::: "memory")
#define PG8_WAIT_L(n) asm volatile("s_waitcnt lgkmcnt(" #n ")" ::: "memory")
#define PG8_BAR __builtin_amdgcn_s_barrier()
#define PG8_SCHED __builtin_amdgcn_sched_barrier(0)
    Unit cur, nxt; int ui = 0;
    if (!S.next(0, cur)) return;
    f32x4 acc[2][2][4][2];
#pragma unroll
    for (int a = 0; a < 2; ++a)
#pragma unroll
        for (int b = 0; b < 2; ++b)
#pragma unroll
            for (int m = 0; m < 4; ++m)
#pragma unroll
                for (int n = 0; n < 2; ++n) acc[a][b][m][n] = (f32x4){0.f, 0.f, 0.f, 0.f};
    bf16x8 At[4][2], B0[2][2], B1[2][2];
    const char* cA = (const char*)g.A + (size_t)cur.pm * tstep; const char* cB = (const char*)g.Bt + (size_t)cur.pn * tstep;
    S.a_ready(cur);
    if constexpr (SP2) {
        PG8_STAGE(PG8_SB(0, 0), cB, voffB); PG8_STAGE(PG8_SB(0, 1), cB + hstep, voffB); PG8_STAGE(PG8_SA(0, 0), cA, voffA); PG8_STAGE(PG8_SA(0, 1), cA + hstep, voffA);
        if (wr == 1) PG8_BAR;
        PG8_WAIT_V(2); PG8_BAR;
        PG8_STAGE(PG8_SB(1, 0), cB + kstep, voffB); PG8_STAGE(PG8_SA(1, 0), cA + kstep, voffA); PG8_STAGE(PG8_SB(1, 1), cB + hstep + kstep, voffB);
        PG8_WAIT_V(6); PG8_BAR;
    } else {
        PG8_STAGE(PG8_SB(0, 0), cB, voffB); PG8_STAGE(PG8_SA(0, 0), cA, voffA); PG8_STAGE(PG8_SB(0, 1), cB + hstep, voffB); PG8_STAGE(PG8_SA(0, 1), cA + hstep, voffA);
        if (wr == 1) PG8_BAR;
        PG8_WAIT_V(4); PG8_BAR;
        PG8_STAGE(PG8_SB(1, 0), cB + kstep, voffB); PG8_STAGE(PG8_SA(1, 0), cA + kstep, voffA); PG8_STAGE(PG8_SB(1, 1), cB + hstep + kstep, voffB);
        PG8_WAIT_V(6); PG8_BAR;
    }
    for (;;) {
        const bool has_next = S.next(ui + 1, nxt);
        const char* nA = has_next ? (const char*)g.A + (size_t)nxt.pm * tstep : cA; const char* nB = has_next ? (const char*)g.Bt + (size_t)nxt.pn * tstep : cB;
        for (int t = 0; t < nt; t += 2) {
            const bool last = (t == nt - 2);
            const char* a1 = cA + (size_t)(t + 1) * kstep;
            const char* a2 = last ? nA : cA + (size_t)(t + 2) * kstep; const char* b2 = last ? nB : cB + (size_t)(t + 2) * kstep;
            const char* a3 = a2 + kstep; const char* b3 = b2 + kstep;
            if (last && has_next) S.a_ready(nxt);
            if constexpr (SP2) {
            PG8_LDB(B0, 0, 0); PG8_LDB(B1, 0, 1); PG8_SCHED; PG8_LDA(At, 0, 0); PG8_STAGE(PG8_SA(1, 1), a1 + hstep, voffA);
            PG8_WAIT_V(8); PG8_WAIT_L(0); PG8_BAR; PG8_MMA(0, 0, At, B0); PG8_MMA(0, 1, At, B1); PG8_BAR; PG8_SCHED;
            PG8_LDA(At, 0, 1); PG8_STAGE(PG8_SB(0, 0), b2, voffB); PG8_STAGE(PG8_SB(0, 1), b2 + hstep, voffB); PG8_STAGE(PG8_SA(0, 0), a2, voffA);
            PG8_WAIT_V(8); PG8_WAIT_L(0); PG8_BAR; PG8_MMA(1, 0, At, B0); PG8_MMA(1, 1, At, B1); PG8_BAR; PG8_SCHED;
            PG8_LDB(B0, 1, 0); PG8_LDB(B1, 1, 1); PG8_SCHED; PG8_LDA(At, 1, 0); PG8_STAGE(PG8_SA(0, 1), a2 + hstep, voffA);
            PG8_WAIT_V(8); PG8_WAIT_L(0); PG8_BAR; PG8_MMA(0, 0, At, B0); PG8_MMA(0, 1, At, B1); PG8_BAR; PG8_SCHED;
            PG8_LDA(At, 1, 1); PG8_STAGE(PG8_SB(1, 0), b3, voffB); PG8_STAGE(PG8_SB(1, 1), b3 + hstep, voffB); PG8_STAGE(PG8_SA(1, 0), a3, voffA);
            PG8_WAIT_V(8); PG8_WAIT_L(0); PG8_BAR; PG8_MMA(1, 0, At, B0); PG8_MMA(1, 1, At, B1); PG8_BAR; PG8_SCHED;
            } else {
            PG8_LDB(B0, 0, 0); PG8_SCHED; PG8_LDA(At, 0, 0); PG8_STAGE(PG8_SA(1, 1), a1 + hstep, voffA);
            PG8_WAIT_L(8); PG8_BAR; PG8_WAIT_L(0); PG8_MMA(0, 0, At, B0); PG8_BAR; PG8_SCHED;
            PG8_LDB(B1, 0, 1); PG8_STAGE(PG8_SB(0, 0), b2, voffB);
            PG8_BAR; PG8_WAIT_L(0); PG8_MMA(0, 1, At, B1); PG8_BAR;
            PG8_LDA(At, 0, 1); PG8_STAGE(PG8_SA(0, 0), a2, voffA);
            PG8_BAR; PG8_WAIT_L(0); PG8_MMA(1, 0, At, B0); PG8_BAR; PG8_SCHED;
            PG8_STAGE(PG8_SB(0, 1), b2 + hstep, voffB);
            PG8_WAIT_V(6); PG8_BAR; PG8_MMA(1, 1, At, B1); PG8_BAR;
            PG8_LDB(B0, 1, 0); PG8_SCHED; PG8_LDA(At, 1, 0); PG8_STAGE(PG8_SA(0, 1), a2 + hstep, voffA);
            PG8_WAIT_L(8); PG8_BAR; PG8_WAIT_L(0); PG8_MMA(0, 0, At, B0); PG8_BAR; PG8_SCHED;
            PG8_LDB(B1, 1, 1); PG8_STAGE(PG8_SB(1, 0), b3, voffB);
            PG8_BAR; PG8_WAIT_L(0); PG8_MMA(0, 1, At, B1); PG8_BAR;
            PG8_LDA(At, 1, 1); PG8_STAGE(PG8_SA(1, 0), a3, voffA);
            PG8_BAR; PG8_WAIT_L(0); PG8_MMA(1, 0, At, B0); PG8_BAR; PG8_SCHED;
            PG8_STAGE(PG8_SB(1, 1), b3 + hstep, voffB);
            PG8_WAIT_V(6); PG8_BAR; PG8_MMA(1, 1, At, B1); PG8_BAR;
            }
        }
        if constexpr (ALIGN_EPI) { if (wr == 0) PG8_BAR; }
        if constexpr (!Epi::AFTER_DRAIN) { E(acc, cur, wr, wc, fr, fq); S.done(cur); }
        if (!has_next) break;
#pragma unroll
        for (int a = 0; a < 2; ++a)
#pragma unroll
            for (int b = 0; b < 2; ++b)
#pragma unroll
                for (int m = 0; m < 4; ++m)
#pragma unroll
                    for (int n = 0; n < 2; ++n) acc[a][b][m][n] = (f32x4){0.f, 0.f, 0.f, 0.f};
        cur = nxt; cA = nA; cB = nB; ++ui;
        if constexpr (ALIGN_EPI) { if (wr == 1) PG8_BAR; }
    }
    PG8_WAIT_V(0);
    if constexpr (!ALIGN_EPI) { if (wr == 0) PG8_BAR; }
    PG8_BAR;
    if constexpr (Epi::AFTER_DRAIN) { E.fused(acc, cur, wr, wc, fr, fq, lds, wid, lane); S.done(cur); }
#undef PG8_SA
#undef PG8_SB
#undef PG8_STAGE
#undef PG8_LDA
#undef PG8_LDB
#undef PG8_MMA
#undef PG8_WAIT_V
#undef PG8_WAIT_L
#undef PG8_BAR
#undef PG8_SCHED
}
}
#define XB_TMO      128
#define XB_XCNT(j)  (256  + 64 * (j))
#define XB_XSUB(j)  (1280 + 64 * (j))
#define XB_XGEN(j)  (2304 + 64 * (j))
#define XB_TOP      3328
#define XB_TOPGEN   3392
#define XCD_BAR_WORDS 3456
#define XB_SPIN_CAP (1u << 18)

__device__ __forceinline__ unsigned xb_ld(unsigned* p)              { return __hip_atomic_load(p, __ATOMIC_RELAXED, __HIP_MEMORY_SCOPE_AGENT); }
__device__ __forceinline__ unsigned xb_add(unsigned* p, unsigned v) { return __hip_atomic_fetch_add(p, v, __ATOMIC_RELAXED, __HIP_MEMORY_SCOPE_AGENT); }
__device__ __forceinline__ unsigned xb_xcc_id() { return (unsigned)__builtin_amdgcn_s_getreg((3 << 11) | 20) & 0xFu; }
#define XB_SPIN(cond, bar) do { unsigned _sp = 0; while (cond) { __builtin_amdgcn_s_sleep(1); \
    if ((++_sp & 255u) == 0u) { if (xb_ld(&(bar)[XB_TMO])) break; if (_sp > XB_SPIN_CAP) { atomicAdd(&(bar)[XB_TMO], 1u); break; } } } } while (0)

struct XcdBarrier {
    unsigned* bar; unsigned x;
    volatile LAS unsigned* st;
};

__device__ __forceinline__ XcdBarrier xcd_barrier_post(unsigned* bar, volatile LAS unsigned* st) {
    XcdBarrier b; b.bar = bar; b.x = xb_xcc_id(); b.st = st;
    if (threadIdx.x == 0) (void)xb_add(&bar[XB_XCNT(b.x)], 1u);
    return b;
}
__device__ __forceinline__ void xcd_barrier_complete(unsigned* bar, unsigned x, unsigned& nloc, unsigned& nx) {
    const unsigned G = gridDim.x * gridDim.y * gridDim.z;
    unsigned sum, cnt, mine, sp = 0u;
    for (;;) {
        sum = 0u; cnt = 0u; mine = 0u;
#pragma unroll
        for (unsigned j = 0; j < 16; ++j) { const unsigned c = xb_ld(&bar[XB_XCNT(j)]); sum += c; cnt += (c > 0u) ? 1u : 0u; mine = (j == x) ? c : mine; }
        if (sum == G) break;
        __builtin_amdgcn_s_sleep(1);
        if ((++sp & 255u) == 0u) { if (xb_ld(&bar[XB_TMO])) break; if (sp > XB_SPIN_CAP) { atomicAdd(&bar[XB_TMO], 1u); break; } }
    }
    nloc = mine > 0u ? mine : 1u; nx = cnt > 0u ? cnt : 1u;
}

__device__ __forceinline__ void xcd_barrier(const XcdBarrier& b) {
    asm volatile("s_waitcnt vmcnt(0)" ::: "memory");
    __syncthreads();
    if (threadIdx.x == 0) {
        unsigned* bar = b.bar;
        __builtin_amdgcn_s_waitcnt(0);
        unsigned nloc = b.st[0], nx = b.st[1];
        if (nloc == 0u) { xcd_barrier_complete(bar, b.x, nloc, nx); b.st[0] = nloc; b.st[1] = nx; }
        const unsigned old = xb_add(&bar[XB_XSUB(b.x)], 1u);
        const unsigned gen = old / nloc;
        if (old + 1u == (gen + 1u) * nloc) {
            __builtin_amdgcn_fence(__ATOMIC_RELEASE, "agent");
            asm volatile("s_waitcnt vmcnt(0)" ::: "memory");
            const unsigned og = xb_add(&bar[XB_TOP], 1u);
            const unsigned tg = og / nx;
            if (og + 1u == (tg + 1u) * nx) xb_add(&bar[XB_TOPGEN], 1u);
            else XB_SPIN(xb_ld(&bar[XB_TOPGEN]) == tg, bar);
            __builtin_amdgcn_fence(__ATOMIC_ACQUIRE, "agent");
            xb_add(&bar[XB_XGEN(b.x)], 1u);
            asm volatile("s_waitcnt vmcnt(0)" ::: "memory");
        } else {
            XB_SPIN(xb_ld(&bar[XB_XGEN(b.x)]) == gen, bar);
            __builtin_amdgcn_fence(__ATOMIC_ACQUIRE, "agent");
            asm volatile("s_waitcnt vmcnt(0)" ::: "memory");
        }
    }
    __syncthreads();
}
#ifndef MK_LO
#define MK_LO 0
#endif
#ifndef MK_HI
#define MK_HI 3
#endif
struct RotC { double nsa[16]; double swa[8]; };
struct Args { const void* in[28]; float* out; unsigned char* ws; RotC rc; };
struct Ctx { LAS unsigned char* lds; int tid, lane, wave, G, vcu; };
__device__ __forceinline__ Ctx fresh_ctx(const Ctx& C0) { Ctx C = C0; int t = threadIdx.x; asm volatile("" : "+v"(t)); C.tid = t; C.lane = t & 63; C.wave = __builtin_amdgcn_readfirstlane(t >> 6); return C; }

__device__ __forceinline__ void conv_tile(const float* __restrict__ W, int K, int ldw, int col0, int nvalid, int npad, bf16* __restrict__ dst, int row_off, LAS float* scr, int item, int tid) {
    const int nblk = (npad + 255) / 256, kb = item / nblk, nb = item % nblk, k0 = 64 * kb, n0 = 256 * nb;
    { const int c4 = tid & 63, r8 = tid >> 6; const int nn = n0 + 4 * c4; const bool ok = nn < nvalid;
      f32x4 v[8];
#pragma unroll
      for (int i = 0; i < 8; ++i) v[i] = ok ? *(const f32x4*)(W + (size_t)(k0 + 8 * i + r8) * ldw + col0 + nn) : (f32x4){0.f, 0.f, 0.f, 0.f};
#pragma unroll
      for (int i = 0; i < 8; ++i) *(LAS f32x4*)(scr + (8 * i + r8) * 260 + 4 * c4) = v[i]; }
    __syncthreads();
    { const int n = tid >> 1, half = tid & 1; const LAS float* s = scr + (32 * half) * 260 + n;
      if (n0 + n < npad) { bf16* o = dst + (size_t)(row_off + n0 + n) * K + k0 + 32 * half;
#pragma unroll
          for (int q = 0; q < 4; ++q) { v4u x; x.x = pkbf(s[(8 * q + 0) * 260], s[(8 * q + 1) * 260]); x.y = pkbf(s[(8 * q + 2) * 260], s[(8 * q + 3) * 260]); x.z = pkbf(s[(8 * q + 4) * 260], s[(8 * q + 5) * 260]); x.w = pkbf(s[(8 * q + 6) * 260], s[(8 * q + 7) * 260]);
              *(v4u*)(o + 8 * q) = x; } } }
    __syncthreads();
}
#define CONV_JOB(W_, K_, LDW_, COL0_, NV_, NP_, DST_, RO_) { const int ni_ = ((K_) / 64) * (((NP_) + 255) / 256); if (r < ni_) { conv_tile((const float*)(W_), (K_), (LDW_), (COL0_), (NV_), (NP_), (bf16*)(DST_), (RO_), scr, r, C.tid); continue; } r -= ni_; }
__device__ __forceinline__ void conv_layer(const Ctx& C0, const Args& A, int layer) {
    const Ctx C = fresh_ctx(C0);
    LAS float* scr = (LAS float*)C.lds;
    const int G = C.G, v = C.vcu;
    unsigned char* ws = A.ws;
    if (layer == 0 || layer == 3) {
        const int b = layer == 0 ? 3 : 23;
        for (int it = v; it < 1024 + 256; it += G) { int r = it;
            CONV_JOB(A.in[b], 2048, 8192, 0, 8192, 8192, ws + WS_WIN, 0)
            CONV_JOB(A.in[b + 2], 2048, 2048, 0, 2048, 2048, ws + WS_WOUT, 0) }
    } else if (layer == 1) {
        for (int it = v; it < 256 + 384 + 256 + 32 + 64 + 64 + 4 + 4 + 256; it += G) { int r = it;
            CONV_JOB(A.in[8], 2048, 7216, 0, 2048, 2048, ws + WS_WIN, 0)
            CONV_JOB(A.in[8], 2048, 7216, 2048, 3072, 3072, ws + WS_WIN, 2048)
            CONV_JOB(A.in[8], 2048, 7216, 5168, 2048, 2048, ws + WS_WIN, 5120)
            CONV_JOB(A.in[8], 2048, 7216, 5120, 48, 64, ws + WS_WIN, 7168)
            CONV_JOB(A.in[10], 4096, 256, 0, 256, 256, ws + WS_W1TK, 0)
            CONV_JOB(A.in[13], 4096, 256, 0, 256, 256, ws + WS_W1TV, 0)
            CONV_JOB(A.in[11], 256, 128, 0, 128, 128, ws + WS_W2TK, 0)
            CONV_JOB(A.in[14], 256, 128, 0, 128, 128, ws + WS_W2TV, 0)
            CONV_JOB(A.in[15], 2048, 2048, 0, 2048, 2048, ws + WS_WOUT, 0) }
    } else {
        for (int it = v; it < 576 + 256; it += G) { int r = it;
            CONV_JOB(A.in[18], 2048, 4608, 0, 4608, 4608, ws + WS_WIN, 0)
            CONV_JOB(A.in[20], 2048, 2048, 0, 2048, 2048, ws + WS_WOUT, 0) }
    }
}
__device__ __forceinline__ void p0_misc(const Ctx& C0, const Args& A) {
    const Ctx C = fresh_ctx(C0);
    unsigned char* ws = A.ws;
    const size_t gt = (size_t)C.vcu * 512 + C.tid, NT = (size_t)C.G * 512;
    { const float* x = MK_LO == 0 ? (const float*)A.in[0] : (const float*)A.out; bf16* hb = (bf16*)(ws + WS_HB);
      for (size_t i = gt; i < (size_t)S * DM / 8; i += 4 * NT) { f32x4 a[4], b[4];
#pragma unroll
          for (int u = 0; u < 4; ++u) if (i + u * NT < (size_t)S * DM / 8) { a[u] = *(const f32x4*)(x + (i + u * NT) * 8); b[u] = *(const f32x4*)(x + (i + u * NT) * 8 + 4); }
#pragma unroll
          for (int u = 0; u < 4; ++u) if (i + u * NT < (size_t)S * DM / 8) { v4u o; o.x = pkbf(a[u][0], a[u][1]); o.y = pkbf(a[u][2], a[u][3]); o.z = pkbf(b[u][0], b[u][1]); o.w = pkbf(b[u][2], b[u][3]); *(v4u*)(hb + (i + u * NT) * 8) = o; } } }
    { const int* pos = (const int*)A.in[1]; float* cn = (float*)(ws + WS_COSN); float* sn = (float*)(ws + WS_SINN); float* cw = (float*)(ws + WS_COSW); float* sw = (float*)(ws + WS_SINW);
      for (size_t idx = gt; idx < (size_t)S * 24; idx += NT) { const int t = (int)(idx / 24), i = (int)(idx % 24); const double f = i < 16 ? A.rc.nsa[i < 16 ? i : 0] : A.rc.swa[i >= 16 ? i - 16 : 0];
          double r = (double)pos[t] * f; r -= floor(r); const float a = (float)(r * 6.283185307179586); const float c = cosf(a), s = sinf(a);
          if (i < 16) { cn[t * 16 + i] = c; sn[t * 16 + i] = s; } else { cw[t * 8 + i - 16] = c; sw[t * 8 + i - 16] = s; } } }
    { const float* lg = (const float*)A.in[2]; float* lbt = (float*)(ws + WS_LB);
      for (size_t c = gt; c < DM; c += NT) { const float a = lg[c], b = lg[DM + c], m = fmaxf(a, b), ea = expf(a - m), eb = expf(b - m), s = ea + eb; const float p0 = ea / s, p1 = eb / s, lb = (p0 + p1) - p0; lbt[c] = lb; } }
    { float* c1p = (float*)(ws + WS_C1P); LAS float* red = (LAS float*)(C.lds + 120000);
      for (int it = C.vcu; it < 128; it += C.G) { const int which = it >> 6, part = it & 63, n = C.tid & 255, half = C.tid >> 8;
          const float* pos = (const float*)A.in[which ? 12 : 9]; const float* w1 = (const float*)A.in[which ? 13 : 10]; float a = 0.f;
          for (int kk = part * 64 + half * 32; kk < part * 64 + half * 32 + 32; ++kk) a = fmaf(pos[kk], w1[(size_t)kk * 256 + n], a);
          if (half) red[n] = a; __syncthreads(); if (!half) c1p[(size_t)it * 256 + n] = a + red[n]; __syncthreads(); } }
}
__device__ __forceinline__ void ln_phase(const Ctx& C0, float* H, bf16* HB, const float* __restrict__ g, const float* __restrict__ b, bool write_hb) {
    const Ctx C = fresh_ctx(C0);
    const int gw = C.vcu * NWAVES + C.wave, NGW = C.G * NWAVES;
    for (int m0 = gw; m0 < S; m0 += 2 * NGW) {
        const int m1 = m0 + NGW; const bool two = m1 < S;
        f32x4* xr0 = (f32x4*)(H + (size_t)m0 * DM) + C.lane; f32x4* xr1 = (f32x4*)(H + (size_t)(two ? m1 : m0) * DM) + C.lane;
        f32x4 v0[8], v1[8]; float s0 = 0.f, s1 = 0.f;
#pragma unroll
        for (int j = 0; j < 8; ++j) { v0[j] = xr0[64 * j]; v1[j] = xr1[64 * j]; }
#pragma unroll
        for (int j = 0; j < 8; ++j) { s0 += (v0[j][0] + v0[j][1]) + (v0[j][2] + v0[j][3]); s1 += (v1[j][0] + v1[j][1]) + (v1[j][2] + v1[j][3]); }
#pragma unroll
        for (int o = 1; o < 64; o <<= 1) { s0 += __shfl_xor(s0, o); s1 += __shfl_xor(s1, o); }
        const float mean0 = s0 * (1.f / DM), mean1 = s1 * (1.f / DM); float q0 = 0.f, q1 = 0.f;
#pragma unroll
        for (int j = 0; j < 8; ++j) { v0[j] = v0[j] - mean0; v1[j] = v1[j] - mean1; q0 += (v0[j][0] * v0[j][0] + v0[j][1] * v0[j][1]) + (v0[j][2] * v0[j][2] + v0[j][3] * v0[j][3]); q1 += (v1[j][0] * v1[j][0] + v1[j][1] * v1[j][1]) + (v1[j][2] * v1[j][2] + v1[j][3] * v1[j][3]); }
#pragma unroll
        for (int o = 1; o < 64; o <<= 1) { q0 += __shfl_xor(q0, o); q1 += __shfl_xor(q1, o); }
        const float rstd0 = 1.f / sqrtf(q0 * (1.f / DM) + LN_EPS), rstd1 = 1.f / sqrtf(q1 * (1.f / DM) + LN_EPS);
        v2u* hb0 = (v2u*)(HB + (size_t)m0 * DM) + C.lane; v2u* hb1 = (v2u*)(HB + (size_t)m1 * DM) + C.lane;
#pragma unroll
        for (int j = 0; j < 8; ++j) { const f32x4 gg = ((const f32x4*)g)[64 * j + C.lane], bb = ((const f32x4*)b)[64 * j + C.lane];
            const f32x4 o0 = v0[j] * rstd0 * gg + bb; xr0[64 * j] = o0; if (write_hb) hb0[64 * j] = pk4(o0);
            if (two) { const f32x4 o1 = v1[j] * rstd1 * gg + bb; xr1[64 * j] = o1; if (write_hb) hb1[64 * j] = pk4(o1); } }
    }
}

__device__ __forceinline__ void hgx_unit(const Ctx& C0, unsigned char* ws, int c, int h) {
    const Ctx C = fresh_ctx(C0);
    LAS unsigned char* lds = C.lds;
    LAS float* Gs = (LAS float*)lds; LAS float* tot = (LAS float*)(lds + 32768);
    LAS unsigned char* QT = lds + 36864; LAS unsigned char* KT = lds + 53248; LAS unsigned char* KE = lds + 69632; LAS unsigned char* VT = lds + 86016;
    const int tid = C.tid, lane = C.lane, w = C.wave; const size_t rowbase = (size_t)c * 64; const int unit = c * 16 + h;
    bf16* QB = (bf16*)(ws + WS_QB); const float* GB = (const float*)(ws + WS_GB); const bf16* VB = (const bf16*)(ws + WS_VB);
    v4u q8r[2], v8r[2];
#pragma unroll
    for (int it = 0; it < 2; ++it) { const int id = tid + 512 * it, t = id >> 4, kc = id & 15; q8r[it] = *(const v4u*)(QB + (rowbase + t) * DM + h * 128 + kc * 8); v8r[it] = *(const v4u*)(VB + (rowbase + t) * DM + h * 128 + kc * 8); }
    { f32x4 gv[4];
#pragma unroll
      for (int i = 0; i < 4; ++i) { const int idx = tid + 512 * i, t = idx >> 5, c4 = idx & 31; gv[i] = *(const f32x4*)(GB + (rowbase + t) * DM + h * 128 + c4 * 4); }
#pragma unroll
      for (int i = 0; i < 4; ++i) { const int idx = tid + 512 * i, t = idx >> 5, c4 = idx & 31; *(LAS f32x4*)(Gs + t * 128 + c4 * 4) = gv[i]; } }
    __syncthreads();
    { const int k = tid & 127, part = tid >> 7; float run = 0.f;
#pragma unroll
      for (int i = 0; i < 16; ++i) { const int t = part * 16 + i; run += Gs[t * 128 + k]; Gs[t * 128 + k] = run; }
      tot[part * 128 + k] = run; }
    __syncthreads();
    { const int k = tid & 127, part = tid >> 7; float off = 0.f;
      for (int p = 0; p < part; ++p) off += tot[p * 128 + k];
      if (part > 0) {
#pragma unroll
          for (int i = 0; i < 16; ++i) Gs[(part * 16 + i) * 128 + k] += off; } }
    __syncthreads();
#pragma unroll
    for (int it = 0; it < 2; ++it) {
        const int id = tid + 512 * it, t = id >> 4, kc = id & 15;
        bf16* qp = QB + (rowbase + t) * DM + h * 128 + kc * 8;
        const v4u q8 = q8r[it]; const v4u v8 = v8r[it];
        float b[8], bp[8], bm[8], be[8];
#pragma unroll
        for (int j = 0; j < 8; ++j) { b[j] = Gs[t * 128 + kc * 8 + j]; bp[j] = t > 0 ? Gs[(t - 1) * 128 + kc * 8 + j] : 0.f; bm[j] = Gs[31 * 128 + kc * 8 + j]; be[j] = Gs[63 * 128 + kc * 8 + j]; }
        float qt[8], kt[8], qb[8], ke[8];
#pragma unroll
        for (int j = 0; j < 8; ++j) { const unsigned wq = j < 2 ? q8.x : j < 4 ? q8.y : j < 6 ? q8.z : q8.w; const float q = (j & 1) ? bfhi(wq) : bflo(wq);
            const float kk = 1.f - __expf(b[j] - bp[j]);
            qt[j] = q * __expf(fminf(b[j] - bm[j], 80.f)); kt[j] = kk * __expf(fminf(bm[j] - b[j], 80.f)); qb[j] = q * __expf(b[j]); ke[j] = kk * __expf(be[j] - b[j]); }
        v4u o; o.x = pkbf(qt[0], qt[1]); o.y = pkbf(qt[2], qt[3]); o.z = pkbf(qt[4], qt[5]); o.w = pkbf(qt[6], qt[7]);
        *(LAS v4u*)(QT + t * 256 + ((kc ^ (t & 15)) << 4)) = o;
        o.x = pkbf(kt[0], kt[1]); o.y = pkbf(kt[2], kt[3]); o.z = pkbf(kt[4], kt[5]); o.w = pkbf(kt[6], kt[7]);
        *(LAS v4u*)(KT + t * 256 + ((kc ^ (t & 15)) << 4)) = o;
        o.x = pkbf(qb[0], qb[1]); o.y = pkbf(qb[2], qb[3]); o.z = pkbf(qb[4], qb[5]); o.w = pkbf(qb[6], qb[7]);
        *(v4u*)qp = o;
#pragma unroll
        for (int j = 0; j < 8; ++j) { const int k = kc * 8 + j; const unsigned wv = j < 2 ? v8.x : j < 4 ? v8.y : j < 6 ? v8.z : v8.w;
            *(LAS unsigned short*)(KE + k * 128 + (((t >> 3) ^ ((k >> 1) & 7)) << 4) + (t & 7) * 2) = (unsigned short)(pkbf(ke[j], 0.f) & 0xffffu);
            *(LAS unsigned short*)(VT + k * 128 + (((t >> 3) ^ ((k >> 1) & 7)) << 4) + (t & 7) * 2) = (unsigned short)((j & 1) ? (wv >> 16) : (wv & 0xffffu)); }
    }
    if (tid < 128) ((float*)(ws + WS_DD))[(size_t)unit * 128 + tid] = __expf(Gs[63 * 128 + tid]);
    __syncthreads();
    const int l15 = lane & 15, l4 = lane >> 4;
    {
        bf16* AM = (bf16*)(ws + WS_AM) + (size_t)unit * 4096; const int tn = w & 3;
        bf16x8 bq[4];
#pragma unroll
        for (int ks = 0; ks < 4; ++ks) { const int row = 16 * tn + l15; bq[ks] = ld_frag(QT + row * 256 + (((ks * 4 + l4) ^ (row & 15)) << 4)); }
#pragma unroll
        for (int i = 0; i < 2; ++i) { const int sm = 2 * (w >> 2) + i; f32x4 acc = {0.f, 0.f, 0.f, 0.f};
#pragma unroll
            for (int ks = 0; ks < 4; ++ks) { const int row = 16 * sm + l15; acc = mfma16(ld_frag(KT + row * 256 + (((ks * 4 + l4) ^ (row & 15)) << 4)), bq[ks], acc); }
            const int t = 16 * tn + l15, s0 = 16 * sm + 4 * l4;
#pragma unroll
            for (int e = 0; e < 4; ++e) if (s0 + e > t) acc[e] = 0.f;
            *(v2u*)(AM + t * 64 + s0) = pk4(acc); }
    }
    {
        bf16* UT = (bf16*)(ws + WS_UT) + (size_t)unit * 16384; const int vrow = 16 * w + l15;
        bf16x8 bv[2];
#pragma unroll
        for (int ks = 0; ks < 2; ++ks) bv[ks] = ld_frag(VT + vrow * 128 + (((ks * 4 + l4) ^ ((vrow >> 1) & 7)) << 4));
#pragma unroll
        for (int km = 0; km < 8; ++km) { f32x4 acc = {0.f, 0.f, 0.f, 0.f}; const int krow = 16 * km + l15;
#pragma unroll
            for (int ks = 0; ks < 2; ++ks) acc = mfma16(ld_frag(KE + krow * 128 + (((ks * 4 + l4) ^ ((krow >> 1) & 7)) << 4)), bv[ks], acc);
            *(v2u*)(UT + vrow * 128 + 16 * km + 4 * l4) = pk4(acc); }
    }
    __syncthreads();
}

__device__ __forceinline__ void hgy_phase(const Ctx& C0, unsigned char* ws) {
    const Ctx C = fresh_ctx(C0);
    if (C.wave >= 2) return;
    const int gw = C.wave * C.G + C.vcu; if (gw >= 512) return;
    const int L = gw * 64 + C.lane, h = L >> 11, v = (L >> 4) & 127, kc = L & 15;
    bf16* UT = (bf16*)(ws + WS_UT) + (size_t)h * 16384 + v * 128 + kc * 8; const float* DD = (const float*)(ws + WS_DD) + (size_t)h * 128 + kc * 8;
    float st[8];
#pragma unroll
    for (int j = 0; j < 8; ++j) st[j] = 0.f;
    for (int c0 = 0; c0 < 128; c0 += 8) {
        v4u u[8]; f32x4 d0[8], d1[8];
#pragma unroll
        for (int i = 0; i < 8; ++i) { u[i] = *(const v4u*)(UT + (size_t)(c0 + i) * 16 * 16384); d0[i] = *(const f32x4*)(DD + (size_t)(c0 + i) * 16 * 128); d1[i] = *(const f32x4*)(DD + (size_t)(c0 + i) * 16 * 128 + 4); }
#pragma unroll
        for (int i = 0; i < 8; ++i) {
            v4u o; o.x = pkbf(st[0], st[1]); o.y = pkbf(st[2], st[3]); o.z = pkbf(st[4], st[5]); o.w = pkbf(st[6], st[7]);
            *(v4u*)(UT + (size_t)(c0 + i) * 16 * 16384) = o;
            const unsigned uw[4] = {u[i].x, u[i].y, u[i].z, u[i].w};
#pragma unroll
            for (int j = 0; j < 8; ++j) { const float d = j < 4 ? d0[i][j & 3] : d1[i][j & 3]; const float uu = (j & 1) ? bfhi(uw[j >> 1]) : bflo(uw[j >> 1]); st[j] = fmaf(d, st[j], uu); } }
    }
}
__device__ __forceinline__ void hgz_unit(const Ctx& C0, unsigned char* ws, int c, int h, const float* __restrict__ gnorm) {
    const Ctx C = fresh_ctx(C0);
    LAS unsigned char* lds = C.lds; const int tid = C.tid, lane = C.lane, w = C.wave, l15 = lane & 15, l4 = lane >> 4;
    const bf16* QB = (const bf16*)(ws + WS_QB); const bf16* VB = (const bf16*)(ws + WS_VB); const bf16* ZS = (const bf16*)(ws + WS_ZS); bf16* HB = (bf16*)(ws + WS_HB);
    const int unit = c * 16 + h; const size_t rb = (size_t)c * 64;
    const bf16* AMg = (const bf16*)(ws + WS_AM) + (size_t)unit * 4096; const bf16* Sg = (const bf16*)(ws + WS_UT) + (size_t)unit * 16384;
    LAS float* red = (LAS float*)(lds + 40960);
    LAS float* rtab = (LAS float*)(lds + 40960 + 2048);
#pragma unroll
    for (int it = 0; it < 2; ++it) { const int id = tid + 512 * it, t = id >> 4, c16 = id & 15;
        *(LAS v4u*)(lds + t * 256 + ((c16 ^ (t & 15)) << 4)) = *(const v4u*)(QB + (rb + t) * DM + h * 128 + c16 * 8);
        *(LAS v4u*)(lds + 24576 + t * 256 + ((((c16 >> 1) ^ ((t & 3) | (((t >> 3) & 1) << 2))) << 5) | ((c16 & 1) << 4))) = *(const v4u*)(VB + (rb + t) * DM + h * 128 + c16 * 8); }
    { const int t = tid >> 3, c8 = tid & 7; *(LAS v4u*)(lds + 16384 + t * 128 + ((c8 ^ ((t >> 1) & 7)) << 4)) = *(const v4u*)(AMg + tid * 8); }
    bf16x8 sf[4];
#pragma unroll
    for (int ks = 0; ks < 4; ++ks) sf[ks] = *(const bf16x8*)(Sg + (16 * w + l15) * 128 + 32 * ks + 8 * l4);
    const int vcol = h * 128 + 16 * w + l15; const float gn = gnorm[vcol];
    float zv[16];
#pragma unroll
    for (int m = 0; m < 4; ++m)
#pragma unroll
        for (int e = 0; e < 4; ++e) zv[m * 4 + e] = bf2f(ZS[(rb + 16 * m + 4 * l4 + e) * DM + vcol]);
    __syncthreads();
    f32x4 o[4];
#pragma unroll
    for (int m = 0; m < 4; ++m) o[m] = (f32x4){0.f, 0.f, 0.f, 0.f};
#pragma unroll
    for (int ks = 0; ks < 4; ++ks)
#pragma unroll
        for (int m = 0; m < 4; ++m) { const int row = 16 * m + l15; o[m] = mfma16(ld_frag(lds + row * 256 + (((ks * 4 + l4) ^ (row & 15)) << 4)), sf[ks], o[m]); }
#pragma unroll
    for (int ss = 0; ss < 2; ++ss) {
        const int q = l15 >> 2, p = l15 & 3; const int s_lo = 32 * ss + 8 * l4 + q, s_hi = s_lo + 4;
        const s16x4 lo = tr_rd(lds + 24576 + s_lo * 256 + ((w ^ ((s_lo & 3) | (((s_lo >> 3) & 1) << 2))) << 5) + p * 8);
        const s16x4 hi = tr_rd(lds + 24576 + s_hi * 256 + ((w ^ ((s_hi & 3) | (((s_hi >> 3) & 1) << 2))) << 5) + p * 8);
        const bf16x8 vf = __builtin_shufflevector(lo, hi, 0, 1, 2, 3, 4, 5, 6, 7);
#pragma unroll
        for (int m = 0; m < 4; ++m) { const int row = 16 * m + l15; o[m] = mfma16(ld_frag(lds + 16384 + row * 128 + (((ss * 4 + l4) ^ ((row >> 1) & 7)) << 4)), vf, o[m]); } }
#pragma unroll
    for (int m = 0; m < 4; ++m)
#pragma unroll
        for (int e = 0; e < 4; ++e) { float sq = o[m][e] * o[m][e]; sq += __shfl_xor(sq, 1); sq += __shfl_xor(sq, 2); sq += __shfl_xor(sq, 4); sq += __shfl_xor(sq, 8);
            if (l15 == 0) red[(16 * m + 4 * l4 + e) * 8 + w] = sq; }
    __syncthreads();
    if (tid < 64) { const f32x4 a = *(const LAS f32x4*)(red + tid * 8), b = *(const LAS f32x4*)(red + tid * 8 + 4);
        const float s = ((a[0] + a[1]) + (a[2] + a[3])) + ((b[0] + b[1]) + (b[2] + b[3])); rtab[tid] = 1.f / sqrtf(s * (1.f / 128.f) + RMS_EPS); }
    __syncthreads();
#pragma unroll
    for (int m = 0; m < 4; ++m) { const f32x4 ri = *(const LAS f32x4*)(rtab + 16 * m + 4 * l4);
#pragma unroll
        for (int e = 0; e < 4; ++e) HB[(rb + 16 * m + 4 * l4 + e) * DM + vcol] = (unsigned short)(pkbf(o[m][e] * ri[e] * gn * zv[m * 4 + e], 0.f) & 0xffffu); }
    __syncthreads();
}

__device__ __forceinline__ void nsa_cmp_unit(const Ctx& C0, unsigned char* ws, int unit) {
    const Ctx C = fresh_ctx(C0);
    LAS unsigned char* lds = C.lds; const int tid = C.tid, lane = C.lane, w = C.wave, l15 = lane & 15, l4 = lane >> 4;
    const int which = unit >> 7, mt = unit & 127;
    const bf16* Asrc = (const bf16*)(ws + WS_KV + (size_t)which * KV_SLOT) + (size_t)mt * 16 * 2048;
    const bf16* W1T = (const bf16*)(ws + (which ? WS_W1TV : WS_W1TK)); const bf16* W2T = (const bf16*)(ws + (which ? WS_W2TV : WS_W2TK));
    const float* c1p = (const float*)(ws + WS_C1P) + (size_t)which * 64 * 256;
    LAS unsigned char* As = lds; LAS unsigned char* Hs = lds + 69632; LAS float* c1s = (LAS float*)(lds + 77824);
    for (int idx = tid; idx < 4352; idx += 512) { const int T = idx >> 4, c16 = idx & 15; v4u x = {0u, 0u, 0u, 0u}; if (mt * 256 + T < 4 * S) x = *(const v4u*)(Asrc + (size_t)idx * 8);
        *(LAS v4u*)(As + T * 256 + ((c16 ^ ((T >> 4) & 15)) << 4)) = x; }
    if (tid < 256) { float a = 0.f; for (int p = 0; p < 64; ++p) a += c1p[p * 256 + tid]; c1s[tid] = a; }
    __syncthreads();
    f32x4 acc[2] = {{0.f, 0.f, 0.f, 0.f}, {0.f, 0.f, 0.f, 0.f}};
    const bf16* b0p = W1T + (size_t)(32 * w + l15) * 4096 + 8 * l4; const bf16* b1p = b0p + (size_t)16 * 4096;
#pragma unroll 4
    for (int ks = 0; ks < 128; ++ks) { const int T = 16 * l15 + (ks >> 2), c16 = (ks & 3) * 4 + l4;
        const bf16x8 a = ld_frag(As + T * 256 + ((c16 ^ ((T >> 4) & 15)) << 4));
        acc[0] = mfma16(a, *(const bf16x8*)(b0p + ks * 32), acc[0]); acc[1] = mfma16(a, *(const bf16x8*)(b1p + ks * 32), acc[1]); }
#pragma unroll
    for (int nt = 0; nt < 2; ++nt) { const int n = 32 * w + 16 * nt + l15; const float cc = c1s[n];
#pragma unroll
        for (int e = 0; e < 4; ++e) { const int m = 4 * l4 + e; *(LAS unsigned short*)(Hs + m * 512 + ((((n >> 3) ^ m) & 31) << 4) + (n & 7) * 2) = (unsigned short)(pkbf(fsilu(acc[nt][e] + cc), 0.f) & 0xffffu); } }
    __syncthreads();
    f32x4 a2 = {0.f, 0.f, 0.f, 0.f};
#pragma unroll
    for (int ks = 0; ks < 8; ++ks) a2 = mfma16(ld_frag(Hs + l15 * 512 + ((((ks * 4 + l4) ^ l15) & 31) << 4)), *(const bf16x8*)(W2T + (size_t)(16 * w + l15) * 256 + ks * 32 + 8 * l4), a2);
    bf16* CB = (bf16*)(ws + WS_CB) + ((size_t)which * 2048 + 16 * mt) * 128;
#pragma unroll
    for (int e = 0; e < 4; ++e) CB[(4 * l4 + e) * 128 + 16 * w + l15] = (((16 * mt + 4 * l4 + e) & 511) == 511) ? (unsigned short)0 : (unsigned short)(pkbf(a2[e], 0.f) & 0xffffu);
    __syncthreads();
}

template <int DT> __device__ __forceinline__ void stage_issue(const bf16* Kg, const bf16* Vg, size_t key0, LAS unsigned char* Kt, LAS unsigned char* Vt, int tid, int wave, bool withv) {
    constexpr int CPR = DT * 4;
    asm volatile("" : "+v"(tid));
#pragma unroll
    for (int it = 0; it < DT / 2; ++it) { const int L = it * 512 + tid, key = L / CPR, cs = L % CPR, c = DT == 4 ? (cs ^ (key & 15)) : (cs ^ ((key >> 1) & 7));
        __builtin_amdgcn_global_load_lds((const unsigned*)(Kg + (key0 + key) * (DT * 32) + c * 8), (LAS unsigned*)(Kt + (it * 512 + wave * 64) * 16), 16, 0, 0);
        if (withv) { const int dt = L >> 8, vkey = (L >> 2) & 63, vc = dt * 4 + (L & 3);
            __builtin_amdgcn_global_load_lds((const unsigned*)(Vg + (key0 + vkey) * (DT * 32) + vc * 8), (LAS unsigned*)(Vt + (it * 512 + wave * 64) * 16), 16, 0, 0); } }
}
#define SBAR() __builtin_amdgcn_sched_barrier(0)
template <int DT> __device__ __forceinline__ void qk_tile(f32x16 (&p)[2], float cinit, const bf16x8 (&qf)[2 * DT], const LAS unsigned char* Kt, int r32, int hi) {
#pragma unroll
    for (int i = 0; i < 16; ++i) { p[0][i] = cinit; p[1][i] = cinit; }
    asm volatile("" : "+v"(r32));
    const int key0 = r32, key1 = 32 + r32;
    const LAS unsigned char* k0p = Kt + (DT == 4 ? key0 * 256 : key0 * 128); const LAS unsigned char* k1p = Kt + (DT == 4 ? key1 * 256 : key1 * 128);
    const int x0 = DT == 4 ? (key0 & 15) : ((key0 >> 1) & 7), x1 = DT == 4 ? (key1 & 15) : ((key1 >> 1) & 7);
    constexpr int NB = DT;
    bf16x8 f[2][2][2];
#define QK_LOAD(bufi, bi) do { _Pragma("unroll") for (int s_ = 0; s_ < 2; ++s_) { const int s = 2 * (bi) + s_; f[bufi][s_][0] = ld_frag(k0p + (((2 * s + hi) ^ x0) << 4)); f[bufi][s_][1] = ld_frag(k1p + (((2 * s + hi) ^ x1) << 4)); } } while (0)
#define QK_MMA(bufi, bi) do { _Pragma("unroll") for (int s_ = 0; s_ < 2; ++s_) { const int s = 2 * (bi) + s_; p[0] = mfma32(f[bufi][s_][0], qf[s], p[0]); p[1] = mfma32(f[bufi][s_][1], qf[s], p[1]); } } while (0)
    QK_LOAD(0, 0); SBAR(); QK_LOAD(1, 1); SBAR();
    QK_MMA(0, 0); SBAR();
    if (NB > 2) { QK_LOAD(0, 2); SBAR(); }
    QK_MMA(1, 1); SBAR();
    if (NB > 2) { QK_LOAD(1, 3); SBAR(); QK_MMA(0, 2); SBAR(); QK_MMA(1, 3); }
#undef QK_LOAD
#undef QK_MMA
}
#define TRR(dst, addr, off) asm volatile("ds_read_b64_tr_b16 %0, %1 offset:%c2" : "=v"(dst) : "v"(addr), "i"(off) : "memory")
#define WAITL(n) asm volatile("s_waitcnt lgkmcnt(" #n ")" ::: "memory")
__device__ __forceinline__ void pack_p(bf16x8 (&pf)[4], const f32x16 (&p)[2]) {
#pragma unroll
    for (int s = 0; s < 4; ++s) { const int b = 8 * (s & 1); v4u x; x.x = pkbf(p[s >> 1][b], p[s >> 1][b + 1]); x.y = pkbf(p[s >> 1][b + 2], p[s >> 1][b + 3]); x.z = pkbf(p[s >> 1][b + 4], p[s >> 1][b + 5]); x.w = pkbf(p[s >> 1][b + 6], p[s >> 1][b + 7]); pf[s] = __builtin_bit_cast(bf16x8, x); }
}
template <int DT> __device__ __forceinline__ void pv_packed(f32x16 (&o)[DT], const bf16x8 (&pf)[4], const LAS unsigned char* Vt, int lane) {
    asm volatile("" : "+v"(lane));
    const int i16 = lane & 15; const unsigned va = (unsigned)(uintptr_t)(Vt + (4 * (lane >> 5) + (i16 >> 2)) * 64 + ((lane >> 4) & 1) * 32 + (i16 & 3) * 8);
    s16x4 v[2][4][2];
#define PV_LOAD(bufi, d) do { TRR(v[bufi][0][0], va, (d) * 4096); TRR(v[bufi][0][1], va, (d) * 4096 + 512); TRR(v[bufi][1][0], va, (d) * 4096 + 1024); TRR(v[bufi][1][1], va, (d) * 4096 + 1536); \
        TRR(v[bufi][2][0], va, (d) * 4096 + 2048); TRR(v[bufi][2][1], va, (d) * 4096 + 2560); TRR(v[bufi][3][0], va, (d) * 4096 + 3072); TRR(v[bufi][3][1], va, (d) * 4096 + 3584); } while (0)
#define PV_MMA(bufi, d) do { _Pragma("unroll") for (int s = 0; s < 4; ++s) o[d] = mfma32(__builtin_shufflevector(v[bufi][s][0], v[bufi][s][1], 0, 1, 2, 3, 4, 5, 6, 7), pf[s], o[d]); } while (0)
    SBAR(); PV_LOAD(0, 0); PV_LOAD(1, 1); WAITL(8); SBAR();
    PV_MMA(0, 0); SBAR();
    if (DT == 4) {
        PV_LOAD(0, 2); WAITL(8); SBAR(); PV_MMA(1, 1); SBAR();
        PV_LOAD(1, 3); WAITL(8); SBAR(); PV_MMA(0, DT == 4 ? 2 : 0); SBAR();
        WAITL(0); SBAR(); PV_MMA(1, DT == 4 ? 3 : 1);
    } else { WAITL(0); SBAR(); PV_MMA(1, 1); }
#undef PV_LOAD
#undef PV_MMA
}
template <int DT> __device__ __forceinline__ void pv_tile(f32x16 (&o)[DT], const f32x16 (&p)[2], const LAS unsigned char* Vt, int lane) { bf16x8 pf[4]; pack_p(pf, p); pv_packed<DT>(o, pf, Vt, lane); }
constexpr float SM_THR = 8.f;
template <int DT, bool DO_PV = true> __device__ __forceinline__ void tile_update(f32x16 (&o)[DT], float& mref, float& l, bool& fresh, f32x16 (&p)[2], const LAS unsigned char* Vt, int lane) {
    float t0 = fmaxf(fmaxf(p[0][0], p[0][1]), p[1][0]), t1 = fmaxf(fmaxf(p[0][2], p[0][3]), p[1][1]);
#pragma unroll
    for (int i = 4; i < 16; i += 2) { t0 = fmaxf(fmaxf(t0, p[0][i]), p[1][i - 2]); t1 = fmaxf(fmaxf(t1, p[0][i + 1]), p[1][i - 1]); }
    float tm = fmaxf(fmaxf(t0, t1), fmaxf(p[1][14], p[1][15]));
    tm = swap_max(tm);
    const bool need = fresh ? (tm > NEG_INF) : (tm > SM_THR);
    if (__any(need)) {
        const float delta = need ? tm : 0.f; mref += delta; fresh = fresh && !need;
        const float f = __builtin_amdgcn_exp2f(-delta); l *= f;
#pragma unroll
        for (int dt = 0; dt < DT; ++dt)
#pragma unroll
            for (int i = 0; i < 16; ++i) o[dt][i] *= f;
#pragma unroll
        for (int kt = 0; kt < 2; ++kt)
#pragma unroll
            for (int i = 0; i < 16; ++i) p[kt][i] -= delta;
    }
    float ls0 = 0.f, ls1 = 0.f;
#pragma unroll
    for (int i = 0; i < 16; ++i) { p[0][i] = __builtin_amdgcn_exp2f(p[0][i]); p[1][i] = __builtin_amdgcn_exp2f(p[1][i]); ls0 += p[0][i]; ls1 += p[1][i]; }
    l += ls0 + ls1;
    if (DO_PV) pv_tile<DT>(o, p, Vt, lane);
}

#define DBG_CHECK(B, SC) do {} while (0)
#define DBG_KV() do {} while (0)
#define RING_BUF(i) (lds + ((i) % 3) * 32768)
#define RING_WAIT(has_next, NI) do { if (has_next) asm volatile("s_waitcnt vmcnt(" #NI ")" ::: "memory"); else asm volatile("s_waitcnt vmcnt(0)" ::: "memory"); __builtin_amdgcn_s_barrier(); asm volatile("" ::: "memory"); } while (0)
#define RING_END() do { asm volatile("s_waitcnt lgkmcnt(0)" ::: "memory"); __builtin_amdgcn_s_barrier(); asm volatile("" ::: "memory"); } while (0)
__device__ __forceinline__ void nsa_attn_unit(const Ctx& C0, unsigned char* ws, int blk, int g) {
    const Ctx C = fresh_ctx(C0);
#ifdef DIAG_TS
#define UMARK(k) do { if (blockIdx.x == 0 && threadIdx.x == 0 && blk == 127) ((unsigned long long*)((unsigned*)(ws + WS_CTL) + 16384 + 64))[32 + (k)] = __builtin_amdgcn_s_memrealtime(); } while (0)
#else
#define UMARK(k) do {} while (0)
#endif
    UMARK(0);
    LAS unsigned char* lds = C.lds; const int tid = C.tid, lane = C.lane, w = C.wave, r32 = lane & 31, hi = lane >> 5;
    LAS float* IMP = (LAS float*)(lds + 98304); LAS unsigned* SEL = (LAS unsigned*)(lds + 131584); LAS unsigned* UNI = (LAS unsigned*)(lds + 132608); LAS float* EV = (LAS float*)(lds + 132864) + w * 128;
    const int ql = 8 * w + (r32 >> 2), head = 4 * g + (r32 & 3), t = 64 * blk + ql;
    const bf16* QB = (const bf16*)(ws + WS_QB); const float* GATE = (const float*)(ws + WS_GATE); const bf16* ZS = (const bf16*)(ws + WS_ZS); bf16* HB = (bf16*)(ws + WS_HB);
    bf16x8 qf[8];
#pragma unroll
    for (int s = 0; s < 8; ++s) qf[s] = *(const bf16x8*)(QB + (size_t)t * DM + head * 128 + 16 * s + 8 * hi);
    for (int i = tid; i < 8192; i += 512) IMP[i] = 0.f;
    f32x16 o[4], p[2];
#define ACC_PTR() ({ int t_ = t; asm volatile("" : "+v"(t_)); (float*)(ws + WS_ACC) + (size_t)t_ * DM + head * 128 + 4 * hi; })
    {
        const bf16* Kc = (const bf16*)(ws + WS_CB) + (size_t)g * 512 * 128; const bf16* Vc = (const bf16*)(ws + WS_CB) + (size_t)(4 + g) * 512 * 128;
        const int nmaxq = t >= 31 ? (t - 31) >> 4 : -1, ntc = ((4 * blk + 2) >> 6) + 1;
        float m = NEG_INF, l = 0.f;
        asm volatile("s_waitcnt vmcnt(0)" ::: "memory");
        stage_issue<4>(Kc, Vc, 0, RING_BUF(0), RING_BUF(0) + 16384, tid, w, false); if (ntc > 1) stage_issue<4>(Kc, Vc, 64, RING_BUF(1), RING_BUF(1) + 16384, tid, w, false);
        for (int i = 0; i < ntc; ++i) { LAS unsigned char* Kt = RING_BUF(i);
            RING_WAIT(i + 1 < ntc, 2);
            if (i + 2 < ntc) stage_issue<4>(Kc, Vc, (size_t)(i + 2) * 64, RING_BUF(i + 2), RING_BUF(i + 2) + 16384, tid, w, false);
            qk_tile<4>(p, 0.f, qf, Kt, r32, hi);
            float tm = NEG_INF;
#pragma unroll
            for (int kt = 0; kt < 2; ++kt)
#pragma unroll
                for (int e = 0; e < 16; ++e) { if (64 * i + 32 * kt + crow(e, hi) > nmaxq) p[kt][e] = NEG_INF; tm = fmaxf(tm, p[kt][e]); }
            tm = swap_max(tm);
            const float mnew = fmaxf(m, tm), msafe = mnew == NEG_INF ? 0.f : mnew; float ls = 0.f;
#pragma unroll
            for (int kt = 0; kt < 2; ++kt)
#pragma unroll
                for (int e = 0; e < 16; ++e) ls += __builtin_amdgcn_exp2f(p[kt][e] - msafe);
            l = l * __builtin_amdgcn_exp2f(m - msafe) + ls; m = mnew; }
        RING_END();
        UMARK(1);
        l = swap_sum(l);
        const float msafe = m == NEG_INF ? 0.f : m, invl = 1.f / fmaxf(l, 1e-30f);
#pragma unroll
        for (int dt = 0; dt < 4; ++dt)
#pragma unroll
            for (int i = 0; i < 16; ++i) o[dt][i] = 0.f;
        float carry = 0.f;
        stage_issue<4>(Kc, Vc, 0, RING_BUF(0), RING_BUF(0) + 16384, tid, w, true); if (ntc > 1) stage_issue<4>(Kc, Vc, 64, RING_BUF(1), RING_BUF(1) + 16384, tid, w, true);
        for (int i = 0; i < ntc; ++i) { LAS unsigned char* Kt = RING_BUF(i);
            RING_WAIT(i + 1 < ntc, 4);
            if (i + 2 < ntc) stage_issue<4>(Kc, Vc, (size_t)(i + 2) * 64, RING_BUF(i + 2), RING_BUF(i + 2) + 16384, tid, w, true);
            qk_tile<4>(p, 0.f, qf, Kt, r32, hi);
#pragma unroll
            for (int kt = 0; kt < 2; ++kt) {
#pragma unroll
                for (int e = 0; e < 16; ++e) p[kt][e] = (64 * i + 32 * kt + crow(e, hi) > nmaxq) ? 0.f : __builtin_amdgcn_exp2f(p[kt][e] - msafe) * invl;
                float own[4], rcv[4], tot[4];
#pragma unroll
                for (int a = 0; a < 4; ++a) { own[a] = (p[kt][4 * a] + p[kt][4 * a + 1]) + (p[kt][4 * a + 2] + p[kt][4 * a + 3]); rcv[a] = swap_other(p[kt][4 * a + 3], hi); }
#pragma unroll
                for (int a = 0; a < 4; ++a) { const float inc = hi ? rcv[a] : (a == 0 ? carry : rcv[a > 0 ? a - 1 : 0]); tot[a] = own[a] + inc; tot[a] += __shfl_xor(tot[a], 1); tot[a] += __shfl_xor(tot[a], 2); }
                carry = rcv[3];
                if ((r32 & 3) == 0) {
#pragma unroll
                    for (int a = 0; a < 4; ++a) IMP[ql * 128 + 16 * i + 8 * kt + 2 * a + hi] = tot[a]; } }
            pv_tile<4>(o, p, Kt + 16384, lane); }
        RING_END();
        int tg0 = t; asm volatile("" : "+v"(tg0)); const float gate_c = GATE[(size_t)tg0 * 48 + head];
        { float* ACC = ACC_PTR();
#pragma unroll
        for (int dt = 0; dt < 4; ++dt)
#pragma unroll
            for (int a = 0; a < 4; ++a) { f32x4 r; r[0] = gate_c * o[dt][4 * a]; r[1] = gate_c * o[dt][4 * a + 1]; r[2] = gate_c * o[dt][4 * a + 2]; r[3] = gate_c * o[dt][4 * a + 3]; *(f32x4*)(ACC + 32 * dt + 8 * a) = r; } }
    }
    UMARK(2);
    for (int qi = 0; qi < 8; ++qi) { const int qq = 8 * w + qi;
        const int jA = lane, jB = lane + 64; const bool aA = jA <= blk, aB = jB <= blk;
        const float eA = IMP[qq * 128 + jA] + (((jA == 0) || (jA == blk) || (jA == blk - 1)) ? 1.0e4f : 0.f), eB = IMP[qq * 128 + jB] + (((jB == blk) || (jB == blk - 1)) ? 1.0e4f : 0.f);
        const unsigned uA = __float_as_uint(eA), uB = __float_as_uint(eB);
        unsigned T = 0u;
        for (int bit = 30; bit >= 0; --bit) { const unsigned cand = T | (1u << bit);
            const int cnt = __popcll(__ballot(aA && uA >= cand)) + __popcll(__ballot(aB && uB >= cand));
            if (cnt >= 16) T = cand; }
        const unsigned long long gA = __ballot(aA && uA > T), gB = __ballot(aB && uB > T), tA = __ballot(aA && uA == T), tB = __ballot(aB && uB == T);
        const int need = 16 - (__popcll(gA) + __popcll(gB));
        const unsigned long long lt = (1ull << lane) - 1ull;
        const bool sA = (aA && uA > T) || (aA && uA == T && __popcll(tA & lt) < need);
        const bool sB = (aB && uB > T) || (aB && uB == T && (__popcll(tA) + __popcll(tB & lt)) < need);
        const unsigned long long b0 = __ballot(sA), b1 = __ballot(sB);
        if (lane == 0) { SEL[qq * 4 + 0] = (unsigned)b0; SEL[qq * 4 + 1] = (unsigned)(b0 >> 32); SEL[qq * 4 + 2] = (unsigned)b1; SEL[qq * 4 + 3] = (unsigned)(b1 >> 32); } }
    __syncthreads();
    if (tid < 4) { unsigned u = 0; for (int q = 0; q < 64; ++q) u |= SEL[q * 4 + tid]; UNI[tid] = u; }
    __syncthreads();
    unsigned wun[4], uni[4];
#pragma unroll
    for (int k = 0; k < 4; ++k) { uni[k] = __builtin_amdgcn_readfirstlane(UNI[k]); unsigned x = SEL[ql * 4 + k];
#pragma unroll
        for (int o_ = 1; o_ < 64; o_ <<= 1) x |= __shfl_xor(x, o_);
        wun[k] = __builtin_amdgcn_readfirstlane(x); }
#define BIT(arr, j) (((j) < 32 ? arr[0] >> (j) : (j) < 64 ? arr[1] >> ((j) - 32) : (j) < 96 ? arr[2] >> ((j) - 64) : arr[3] >> ((j) - 96)) & 1u)
    UMARK(3);
    {
        const bf16* Kg = (const bf16*)(ws + WS_KV + 2 * KV_SLOT) + (size_t)g * S * 128; const bf16* Vg = (const bf16*)(ws + WS_KV + 3 * KV_SLOT) + (size_t)g * S * 128;
        float m = 0.f, l = 0.f; bool fresh = true;
#pragma unroll
        for (int dt = 0; dt < 4; ++dt)
#pragma unroll
            for (int i = 0; i < 16; ++i) o[dt][i] = 0.f;
        asm volatile("s_waitcnt vmcnt(0)" ::: "memory");
        int j = 0; while (j <= blk && !BIT(uni, j)) ++j;
        int j1 = j + 1; while (j1 <= blk && !BIT(uni, j1)) ++j1;
        if (j <= blk) stage_issue<4>(Kg, Vg, (size_t)j * 64, RING_BUF(0), RING_BUF(0) + 16384, tid, w, true);
        if (j1 <= blk) stage_issue<4>(Kg, Vg, (size_t)j1 * 64, RING_BUF(1), RING_BUF(1) + 16384, tid, w, true);
        int ri = 0;
        while (j <= blk) {
            int j2 = j1 + 1; while (j2 <= blk && !BIT(uni, j2)) ++j2;
            LAS unsigned char* Kt = RING_BUF(ri);
            RING_WAIT(j1 <= blk, 4);
            if (j2 <= blk) stage_issue<4>(Kg, Vg, (size_t)j2 * 64, RING_BUF(ri + 2), RING_BUF(ri + 2) + 16384, tid, w, true);
            if (BIT(wun, j)) {
                const bool sel = ((SEL[ql * 4 + (j >> 5)] >> (j & 31)) & 1u) != 0u;
                qk_tile<4>(p, sel ? -m : NEG_INF, qf, Kt, r32, hi);
                if (j == blk) {
#pragma unroll
                    for (int kt = 0; kt < 2; ++kt)
#pragma unroll
                        for (int e = 0; e < 16; ++e) if (32 * kt + crow(e, hi) > ql) p[kt][e] = NEG_INF; }
                tile_update<4>(o, m, l, fresh, p, Kt + 16384, lane);
            }
            ri = ri == 2 ? 0 : ri + 1; j = j1; j1 = j2; }
        RING_END();
        l = swap_sum(l); int tg1 = t; asm volatile("" : "+v"(tg1)); float sc = GATE[(size_t)tg1 * 48 + 16 + head] / fmaxf(l, 1e-30f); DBG_CHECK(1, sc);
        float* ACC = ACC_PTR();
#pragma unroll
        for (int dt = 0; dt < 4; ++dt)
#pragma unroll
            for (int a = 0; a < 4; ++a) { f32x4 r = *(const f32x4*)(ACC + 32 * dt + 8 * a); r[0] += sc * o[dt][4 * a]; r[1] += sc * o[dt][4 * a + 1]; r[2] += sc * o[dt][4 * a + 2]; r[3] += sc * o[dt][4 * a + 3]; *(f32x4*)(ACC + 32 * dt + 8 * a) = r; }
    }
    UMARK(4);
    {
        const bf16* Kg = (const bf16*)(ws + WS_KV + 4 * KV_SLOT) + (size_t)g * S * 128; const bf16* Vg = (const bf16*)(ws + WS_KV + 5 * KV_SLOT) + (size_t)g * S * 128;
        float m = 0.f, l = 0.f; bool fresh = true;
#pragma unroll
        for (int dt = 0; dt < 4; ++dt)
#pragma unroll
            for (int i = 0; i < 16; ++i) o[dt][i] = 0.f;
        const int j0 = blk >= 8 ? blk - 8 : 0;
        asm volatile("s_waitcnt vmcnt(0)" ::: "memory");
        stage_issue<4>(Kg, Vg, (size_t)j0 * 64, RING_BUF(0), RING_BUF(0) + 16384, tid, w, true); if (j0 + 1 <= blk) stage_issue<4>(Kg, Vg, (size_t)(j0 + 1) * 64, RING_BUF(1), RING_BUF(1) + 16384, tid, w, true);
        for (int j = j0; j <= blk; ++j) { LAS unsigned char* Kt = RING_BUF(j - j0);
            RING_WAIT(j + 1 <= blk, 4);
            if (j + 2 <= blk) stage_issue<4>(Kg, Vg, (size_t)(j + 2) * 64, RING_BUF(j + 2 - j0), RING_BUF(j + 2 - j0) + 16384, tid, w, true);
            qk_tile<4>(p, -m, qf, Kt, r32, hi);
            if (j == blk) {
#pragma unroll
                for (int kt = 0; kt < 2; ++kt)
#pragma unroll
                    for (int e = 0; e < 16; ++e) if (32 * kt + crow(e, hi) > ql) p[kt][e] = NEG_INF; }
            if (j == blk - 8) {
#pragma unroll
                for (int kt = 0; kt < 2; ++kt)
#pragma unroll
                    for (int e = 0; e < 16; ++e) if (32 * kt + crow(e, hi) <= ql) p[kt][e] = NEG_INF; }
            tile_update<4>(o, m, l, fresh, p, Kt + 16384, lane); }
        RING_END();
        l = swap_sum(l); int tg2 = t; asm volatile("" : "+v"(tg2)); float sc = GATE[(size_t)tg2 * 48 + 32 + head] / fmaxf(l, 1e-30f); DBG_CHECK(2, sc);
        float* ACC = ACC_PTR(); int t2 = t; asm volatile("" : "+v"(t2));
#pragma unroll
        for (int dt = 0; dt < 4; ++dt)
#pragma unroll
            for (int a = 0; a < 4; ++a) { const size_t off = (size_t)t2 * DM + head * 128 + 32 * dt + 8 * a + 4 * hi; const v2u z = *(const v2u*)(ZS + off); const f32x4 f = *(const f32x4*)(ACC + 32 * dt + 8 * a);
                f32x4 r; r[0] = (f[0] + sc * o[dt][4 * a]) * bflo(z.x); r[1] = (f[1] + sc * o[dt][4 * a + 1]) * bfhi(z.x); r[2] = (f[2] + sc * o[dt][4 * a + 2]) * bflo(z.y); r[3] = (f[3] + sc * o[dt][4 * a + 3]) * bfhi(z.y);
                *(v2u*)(HB + off) = pk4(r); }
    }
    UMARK(5);
#undef UMARK
#undef BIT
#undef ACC_PTR
#undef RING_BUF
#undef RING_WAIT
#undef RING_END
    __syncthreads();
}

__device__ __forceinline__ void swa_attn_unit(const Ctx& C0, unsigned char* ws, int i32, int kvh, const float* __restrict__ sinks) {
    const Ctx C = fresh_ctx(C0);
    LAS unsigned char* lds = C.lds; const int tid = C.tid, lane = C.lane, w = C.wave, r32 = lane & 31, hi = lane >> 5;
    const int ql = 4 * w + (r32 >> 3), head = kvh * 8 + (r32 & 7), t = 32 * i32 + ql;
    const bf16* QB = (const bf16*)(ws + WS_QB); const bf16* ZS = (const bf16*)(ws + WS_ZS); bf16* HB = (bf16*)(ws + WS_HB);
    const bf16* Kg = (const bf16*)(ws + WS_KS) + (size_t)kvh * S * 64; const bf16* Vg = (const bf16*)(ws + WS_VS) + (size_t)kvh * S * 64;
    bf16x8 qf[4];
#pragma unroll
    for (int s = 0; s < 4; ++s) qf[s] = *(const bf16x8*)(QB + (size_t)t * DM + head * 64 + 16 * s + 8 * hi);
    f32x16 o[2], p[2];
#pragma unroll
    for (int dt = 0; dt < 2; ++dt)
#pragma unroll
        for (int i = 0; i < 16; ++i) o[dt][i] = 0.f;
    float m = 0.f, l = 0.f; bool fresh = true;
    const int klo = 32 * i32 - 127 > 0 ? 32 * i32 - 127 : 0, j0 = klo >> 6, j1 = (32 * i32 + 31) >> 6;
    stage_issue<2>(Kg, Vg, (size_t)j0 * 64, lds, lds + 8192, tid, w, true); __syncthreads();
    for (int j = j0; j <= j1; ++j) { LAS unsigned char* Kt = lds + ((j - j0) & 1) * 16384;
        if (j + 1 <= j1) stage_issue<2>(Kg, Vg, (size_t)(j + 1) * 64, lds + ((j + 1 - j0) & 1) * 16384, lds + ((j + 1 - j0) & 1) * 16384 + 8192, tid, w, true);
        qk_tile<2>(p, -m, qf, Kt, r32, hi);
#pragma unroll
        for (int kt = 0; kt < 2; ++kt)
#pragma unroll
            for (int e = 0; e < 16; ++e) { const int key = 64 * j + 32 * kt + crow(e, hi); if (key > t || key < t - 127) p[kt][e] = NEG_INF; }
        tile_update<2>(o, m, l, fresh, p, Kt + 8192, lane);
        __syncthreads(); }
    l = swap_sum(l) + __builtin_amdgcn_exp2f(sinks[head] * LOG2E - m);
    const float sc = 1.f / l;
#pragma unroll
    for (int dt = 0; dt < 2; ++dt)
#pragma unroll
        for (int a = 0; a < 4; ++a) { const size_t off = (size_t)t * DM + head * 64 + 32 * dt + 8 * a + 4 * hi; const v2u z = *(const v2u*)(ZS + off);
            f32x4 r; r[0] = o[dt][4 * a] * sc * bflo(z.x); r[1] = o[dt][4 * a + 1] * sc * bfhi(z.x); r[2] = o[dt][4 * a + 2] * sc * bflo(z.y); r[3] = o[dt][4 * a + 3] * sc * bfhi(z.y);
            *(v2u*)(HB + off) = pk4(r); }
}
#ifdef HYBRID
namespace nv {

constexpr int S = 8192, D = 2048;
constexpr float ALPHA = 1.681792830507429f;
constexpr float LN_EPS = 1e-5f, RMS_EPS = 1e-6f;
constexpr int HG_IN = 8192, NSA_IN = 7216, SWA_IN = 4608;

using ::RotC;

__device__ __forceinline__ float silu_f(float x) { return x / (1.f + expf(-x)); }
__device__ __forceinline__ float sigmoid_f(float x) { return 1.f / (1.f + expf(-x)); }

__global__ __launch_bounds__(256) void gemm_f32(const float* __restrict__ A, int lda, const float* __restrict__ B, int ldb, float* __restrict__ C, int ldc, int N, int K) {
    __shared__ float As[16][132];
    __shared__ float Bs[16][132];
    const int tid = threadIdx.x, bm = blockIdx.y * 128, bn = blockIdx.x * 128, tx = tid & 15, ty = tid >> 4;
    float acc[8][8];
#pragma unroll
    for (int i = 0; i < 8; ++i)
#pragma unroll
        for (int j = 0; j < 8; ++j) acc[i][j] = 0.f;
    for (int k0 = 0; k0 < K; k0 += 16) {
#pragma unroll
        for (int i = 0; i < 8; ++i) { const int idx = tid + 256 * i, r = idx >> 4, c = idx & 15; As[c][r] = A[(size_t)(bm + r) * lda + k0 + c]; }
#pragma unroll
        for (int i = 0; i < 8; ++i) { const int idx = tid + 256 * i, r = idx >> 7, c = idx & 127; Bs[r][c] = (bn + c < N) ? B[(size_t)(k0 + r) * ldb + bn + c] : 0.f; }
        __syncthreads();
#pragma unroll
        for (int kk = 0; kk < 16; ++kk) {
            float a[8], b[8];
#pragma unroll
            for (int i = 0; i < 8; ++i) a[i] = As[kk][ty * 8 + i];
#pragma unroll
            for (int j = 0; j < 8; ++j) b[j] = Bs[kk][tx * 8 + j];
#pragma unroll
            for (int i = 0; i < 8; ++i)
#pragma unroll
                for (int j = 0; j < 8; ++j) acc[i][j] = fmaf(a[i], b[j], acc[i][j]);
        }
        __syncthreads();
    }
#pragma unroll
    for (int i = 0; i < 8; ++i)
#pragma unroll
        for (int j = 0; j < 8; ++j) { const int c = bn + tx * 8 + j; if (c < N) C[(size_t)(bm + ty * 8 + i) * ldc + c] = acc[i][j]; }
}

__global__ void lb_kernel(const float* __restrict__ logits, float* __restrict__ lb1) {
    const int c = blockIdx.x * blockDim.x + threadIdx.x; if (c >= D) return;
    const float a = logits[c], b = logits[D + c], m = fmaxf(a, b), ea = expf(a - m), eb = expf(b - m), s = ea + eb;
    const float p0 = ea / s, p1 = eb / s; lb1[c] = (p0 + p1) - p0;
}
__global__ void hg_prep(float* __restrict__ proj, const float* __restrict__ lb) {
    const size_t idx = (size_t)blockIdx.x * blockDim.x + threadIdx.x; const int t = (int)(idx / D), c = (int)(idx % D);
    float* p = proj + (size_t)t * HG_IN + 2048 + c; const float l = lb ? lb[c] : 0.f; *p = l + (1.f - l) * sigmoid_f(*p);
}
__global__ __launch_bounds__(64) void hg_scan(float* __restrict__ proj) {
    const int j = blockIdx.x, h = blockIdx.y, lane = threadIdx.x, vi = lane & 15, kg = lane >> 4;
    float s[32];
#pragma unroll
    for (int i = 0; i < 32; ++i) s[i] = 0.f;
    for (int t = 0; t < S; ++t) {
        float* row = proj + (size_t)t * HG_IN;
        const float v = row[4096 + h * 128 + j * 16 + vi];
        float part = 0.f;
#pragma unroll
        for (int i = 0; i < 32; ++i) { const int k = h * 128 + kg * 32 + i; const float q = row[k], f = row[2048 + k]; s[i] = fmaf(f, s[i], (1.f - f) * v); part = fmaf(q, s[i], part); }
        part += __shfl_xor(part, 16); part += __shfl_xor(part, 32);
        if (kg == 0) row[4096 + h * 128 + j * 16 + vi] = part;
    }
}
__global__ __launch_bounds__(256) void hg_norm(float* __restrict__ proj, const float* __restrict__ gn) {
    const int t = blockIdx.x, tid = threadIdx.x; float* row = proj + (size_t)t * HG_IN;
    float o[8], ss = 0.f;
#pragma unroll
    for (int i = 0; i < 8; ++i) { o[i] = row[4096 + tid * 8 + i]; ss += o[i] * o[i]; }
    ss += __shfl_xor(ss, 1); ss += __shfl_xor(ss, 2); ss += __shfl_xor(ss, 4); ss += __shfl_xor(ss, 8);
    const float r = rsqrtf(ss * (1.f / 128.f) + RMS_EPS);
#pragma unroll
    for (int i = 0; i < 8; ++i) { const int c = tid * 8 + i; row[c] = o[i] * r * gn[c] * silu_f(row[6144 + c]); }
}
__global__ __launch_bounds__(256) void res_ln(const float* hin, const float* __restrict__ y, const float* __restrict__ g, const float* __restrict__ b, float* hout) {
    __shared__ float red[8];
    const int t = blockIdx.x, tid = threadIdx.x; float u[8], s = 0.f;
#pragma unroll
    for (int i = 0; i < 8; ++i) { const size_t o = (size_t)t * D + tid * 8 + i; u[i] = ALPHA * hin[o] + y[o]; s += u[i]; }
    for (int o = 1; o < 64; o <<= 1) s += __shfl_xor(s, o);
    if ((tid & 63) == 0) red[tid >> 6] = s; __syncthreads();
    const float mean = (red[0] + red[1] + red[2] + red[3]) * (1.f / D); __syncthreads();
    float q = 0.f;
#pragma unroll
    for (int i = 0; i < 8; ++i) { u[i] -= mean; q += u[i] * u[i]; }
    for (int o = 1; o < 64; o <<= 1) q += __shfl_xor(q, o);
    if ((tid & 63) == 0) red[tid >> 6] = q; __syncthreads();
    const float rstd = rsqrtf((red[0] + red[1] + red[2] + red[3]) * (1.f / D) + LN_EPS);
#pragma unroll
    for (int i = 0; i < 8; ++i) { const int c = tid * 8 + i; hout[(size_t)t * D + c] = u[i] * rstd * g[c] + b[c]; }
}
__global__ void rot_tab(const int* __restrict__ pos, float2* __restrict__ tn, float2* __restrict__ tw, RotC rc) {
    const int idx = blockIdx.x * blockDim.x + threadIdx.x; if (idx >= S * 24) return;
    const int t = idx / 24, i = idx % 24; const double f = i < 16 ? rc.nsa[i] : rc.swa[i - 16];
    double r = (double)pos[t] * f; r -= floor(r); const float a = (float)(r * 6.283185307179586);
    const float2 cs = make_float2(cosf(a), sinf(a));
    if (i < 16) tn[t * 16 + i] = cs; else tw[t * 8 + (i - 16)] = cs;
}
__global__ void nsa_rot(float* __restrict__ proj, const float2* __restrict__ tn) {
    const int idx = blockIdx.x * blockDim.x + threadIdx.x; if (idx >= S * 28 * 16) return;
    const int i = idx & 15, slot = (idx >> 4) % 28, t = idx / (28 * 16);
    const int base = slot < 16 ? slot * 128 : slot < 20 ? 2048 + (slot - 16) * 128 : slot < 24 ? 3072 + (slot - 20) * 128 : 4096 + (slot - 24) * 128;
    float* p = proj + (size_t)t * NSA_IN + base; const float2 cs = tn[t * 16 + i]; const float x1 = p[i], x2 = p[16 + i];
    p[i] = x1 * cs.x - x2 * cs.y; p[16 + i] = x2 * cs.x + x1 * cs.y;
}
__global__ void swa_rot(float* __restrict__ proj, const float2* __restrict__ tw) {
    const int idx = blockIdx.x * blockDim.x + threadIdx.x; if (idx >= S * 36 * 8) return;
    const int i = idx & 7, slot = (idx >> 3) % 36, t = idx / (36 * 8);
    const int base = slot < 32 ? slot * 64 : 2048 + (slot - 32) * 64;
    float* p = proj + (size_t)t * SWA_IN + base; const float2 cs = tw[t * 8 + i]; const float x1 = p[i], x2 = p[8 + i];
    p[i] = x1 * cs.x - x2 * cs.y; p[8 + i] = x2 * cs.x + x1 * cs.y;
}
__global__ __launch_bounds__(256) void nsa_cmp(const float* __restrict__ proj, const float* __restrict__ posk, const float* __restrict__ w1k, const float* __restrict__ w2k,
                                               const float* __restrict__ posv, const float* __restrict__ w1v, const float* __restrict__ w2v, float* __restrict__ cb) {
    __shared__ float flat[4096]; __shared__ float hid[256];
    const int i = blockIdx.x, g = blockIdx.y, which = blockIdx.z, tid = threadIdx.x;
    const float* pos = which ? posv : posk; const float* w1 = which ? w1v : w1k; const float* w2 = which ? w2v : w2k; const int col = which ? 2560 : 2048;
    for (int kk = tid; kk < 4096; kk += 256) flat[kk] = proj[(size_t)(16 * i + (kk >> 7)) * NSA_IN + col + g * 128 + (kk & 127)] + pos[kk];
    __syncthreads();
    float a = 0.f;
    for (int kk = 0; kk < 4096; ++kk) a = fmaf(flat[kk], w1[(size_t)kk * 256 + tid], a);
    hid[tid] = silu_f(a); __syncthreads();
    if (tid < 128) { float o = 0.f; for (int n = 0; n < 256; ++n) o = fmaf(hid[n], w2[n * 128 + tid], o); cb[((size_t)(which * 4 + g) * 512 + i) * 128 + tid] = o; }
}
__device__ __forceinline__ float dot128(const float* __restrict__ q, const float* __restrict__ k) {
    float a = 0.f;
#pragma unroll 8
    for (int d = 0; d < 128; d += 4) { const float4 kv = *(const float4*)(k + d); a = fmaf(q[d], kv.x, a); a = fmaf(q[d + 1], kv.y, a); a = fmaf(q[d + 2], kv.z, a); a = fmaf(q[d + 3], kv.w, a); }
    return a;
}
__device__ __forceinline__ float wave_max(float v) { for (int o = 1; o < 64; o <<= 1) v = fmaxf(v, __shfl_xor(v, o)); return v; }
__device__ __forceinline__ float wave_sum(float v) { for (int o = 1; o < 64; o <<= 1) v += __shfl_xor(v, o); return v; }
__global__ __launch_bounds__(256) void nsa_attn(float* __restrict__ proj, const float* __restrict__ cb) {
    __shared__ float qs[4][128]; __shared__ float pc[4][512]; __shared__ float ps[4][1024]; __shared__ float ev[128]; __shared__ int selflag[128];
    const int t = blockIdx.x, g = blockIdx.y, tid = threadIdx.x, r = tid >> 6, lane = tid & 63, h = 4 * g + r;
    const float scale = 0.08838834764831845f;
    float* row = proj + (size_t)t * NSA_IN;
    qs[r][lane] = row[h * 128 + lane]; qs[r][lane + 64] = row[h * 128 + lane + 64];
    __syncthreads();
    const float* q = qs[r];
    const float* kcb = cb + (size_t)(0 * 4 + g) * 512 * 128; const float* vcb = cb + (size_t)(1 * 4 + g) * 512 * 128;
    const int nvalid = t >= 31 ? (t - 31) / 16 + 1 : 0;
    float m = -INFINITY;
    for (int n = lane; n < 512; n += 64) { float s = -INFINITY; if (n < nvalid) s = scale * dot128(q, kcb + (size_t)n * 128); pc[r][n] = s; m = fmaxf(m, s); }
    m = wave_max(m); if (!(m > -INFINITY)) m = 0.f;
    float l = 0.f;
    for (int n = lane; n < 512; n += 64) { const float e = expf(pc[r][n] - m); pc[r][n] = e; l += e; }
    l = wave_sum(l); const float il = 1.f / fmaxf(l, 1e-30f);
    for (int n = lane; n < 512; n += 64) pc[r][n] *= il;
    float oc0 = 0.f, oc1 = 0.f;
    for (int n = 0; n < nvalid; ++n) { const float p = pc[r][n]; oc0 = fmaf(p, vcb[(size_t)n * 128 + lane], oc0); oc1 = fmaf(p, vcb[(size_t)n * 128 + lane + 64], oc1); }
    __syncthreads();
    const int cur = t >> 6;
    if (tid < 128) { const int j = tid; float imp = 0.f;
        for (int rr = 0; rr < 4; ++rr) for (int n = 4 * j - 1; n <= 4 * j + 3; ++n) if (n >= 0 && n <= 510) imp += pc[rr][n];
        const bool allowed = j * 64 <= t, forced = (j == 0) || (j == cur) || (j == cur - 1);
        ev[j] = allowed ? imp + (forced ? 1.0e4f : 0.f) : -INFINITY; }
    __syncthreads();
    if (tid < 128) { const int j = tid; const float e = ev[j]; int rank = 0;
        for (int i = 0; i < 128; ++i) { const float x = ev[i]; rank += (x > e || (x == e && i < j)) ? 1 : 0; }
        selflag[j] = rank < 16 ? 1 : 0; }
    __syncthreads();
    float os0 = 0.f, os1 = 0.f;
    { int ns = 0; float mm = -INFINITY;
      for (int j = 0; j <= cur; ++j) if (selflag[j]) { const int key = 64 * j + lane; float s = -INFINITY; if (key <= t) s = scale * dot128(q, proj + (size_t)key * NSA_IN + 3072 + g * 128); ps[r][ns * 64 + lane] = s; mm = fmaxf(mm, s); ++ns; }
      mm = wave_max(mm); if (!(mm > -INFINITY)) mm = 0.f; float ll = 0.f;
      for (int i = 0; i < ns; ++i) { const float e = expf(ps[r][i * 64 + lane] - mm); ps[r][i * 64 + lane] = e; ll += e; }
      ll = wave_sum(ll); const float ill = 1.f / fmaxf(ll, 1e-30f);
      ns = 0;
      for (int j = 0; j <= cur; ++j) if (selflag[j]) { for (int kk = 0; kk < 64; ++kk) { const int key = 64 * j + kk; if (key > t) break; const float p = ps[r][ns * 64 + kk]; const float* vr = proj + (size_t)key * NSA_IN + 3584 + g * 128; os0 = fmaf(p, vr[lane], os0); os1 = fmaf(p, vr[lane + 64], os1); } ++ns; }
      os0 *= ill; os1 *= ill; }
    float ow0 = 0.f, ow1 = 0.f;
    { const int k0 = t >= 511 ? t - 511 : 0, nk = t - k0 + 1; float mm = -INFINITY;
      for (int i = lane; i < nk; i += 64) { const float s = scale * dot128(q, proj + (size_t)(k0 + i) * NSA_IN + 4096 + g * 128); ps[r][i] = s; mm = fmaxf(mm, s); }
      mm = wave_max(mm); float ll = 0.f;
      for (int i = lane; i < nk; i += 64) { const float e = expf(ps[r][i] - mm); ps[r][i] = e; ll += e; }
      ll = wave_sum(ll); const float ill = 1.f / fmaxf(ll, 1e-30f);
      for (int i = 0; i < nk; ++i) { const float p = ps[r][i]; const float* vr = proj + (size_t)(k0 + i) * NSA_IN + 4608 + g * 128; ow0 = fmaf(p, vr[lane], ow0); ow1 = fmaf(p, vr[lane + 64], ow1); }
      ow0 *= ill; ow1 *= ill; }
    const float g0 = sigmoid_f(row[5120 + 0 * 16 + h]), g1 = sigmoid_f(row[5120 + 1 * 16 + h]), g2 = sigmoid_f(row[5120 + 2 * 16 + h]);
    const float z0 = row[5168 + h * 128 + lane], z1 = row[5168 + h * 128 + lane + 64];
    row[h * 128 + lane] = (g0 * oc0 + g1 * os0 + g2 * ow0) * silu_f(z0);
    row[h * 128 + lane + 64] = (g0 * oc1 + g1 * os1 + g2 * ow1) * silu_f(z1);
}
__global__ __launch_bounds__(64) void swa_attn(float* __restrict__ proj, const float* __restrict__ sinks) {
    __shared__ float qs[64]; __shared__ float pl[128];
    const int t = blockIdx.x, h = blockIdx.y, kv = h >> 3, lane = threadIdx.x;
    float* row = proj + (size_t)t * SWA_IN;
    qs[lane] = row[h * 64 + lane]; __syncthreads();
    const float sink = sinks[h]; float m = sink; float s2[2];
#pragma unroll
    for (int i = 0; i < 2; ++i) { const int key = t - 127 + lane + 64 * i; float s = -INFINITY;
        if (key >= 0) { const float* kr = proj + (size_t)key * SWA_IN + 2048 + kv * 64; float a = 0.f; for (int d = 0; d < 64; ++d) a = fmaf(qs[d], kr[d], a); s = a * 0.125f; }
        s2[i] = s; m = fmaxf(m, s); }
    m = wave_max(m);
    float l = 0.f;
#pragma unroll
    for (int i = 0; i < 2; ++i) { const float e = expf(s2[i] - m); pl[lane + 64 * i] = e; l += e; }
    l = wave_sum(l) + expf(sink - m); __syncthreads();
    float o = 0.f;
    for (int i = 0; i < 128; ++i) { const int key = t - 127 + i; if (key < 0) continue; o = fmaf(pl[i], proj[(size_t)key * SWA_IN + 2304 + kv * 64 + lane], o); }
    o /= l;
    __syncthreads();
    row[h * 64 + lane] = o * silu_f(row[2560 + h * 64 + lane]);
}

}

static void naive_layers(int l0, int l1, void* const* d_in, float* H, char* ws, hipStream_t stream, const RotC& rc) {
    constexpr int D = nv::D, HG_IN = nv::HG_IN, NSA_IN = nv::NSA_IN, SWA_IN = nv::SWA_IN;
    const size_t MiB = 1u << 20;
    auto F = [&](int i) { return (const float*)d_in[i]; };
    float* proj = (float*)ws; float* Y = (float*)(ws + 256 * MiB); float* lb1 = (float*)(ws + 320 * MiB); float2* tn = (float2*)(ws + 321 * MiB); float2* tw = (float2*)(ws + 323 * MiB); float* cb = (float*)(ws + 324 * MiB);
    if (l0 > l1) return;
    nv::lb_kernel<<<D / 256, 256, 0, stream>>>(F(2), lb1);
    nv::rot_tab<<<(S * 24 + 255) / 256, 256, 0, stream>>>((const int*)d_in[1], tn, tw, rc);
    (void)hipMemsetAsync(cb, 0, 2 * MiB, stream);
    const float* hin = l0 == 0 ? F(0) : H;
    for (int layer = l0; layer <= l1; ++layer) {
        if (layer == 0 || layer == 3) {
            const int b = layer == 0 ? 3 : 23;
            nv::gemm_f32<<<dim3(HG_IN / 128, S / 128), 256, 0, stream>>>(hin, D, F(b), HG_IN, proj, HG_IN, HG_IN, D);
            nv::hg_prep<<<S * D / 256, 256, 0, stream>>>(proj, layer == 0 ? nullptr : lb1);
            nv::hg_scan<<<dim3(8, 16), 64, 0, stream>>>(proj);
            nv::hg_norm<<<S, 256, 0, stream>>>(proj, F(b + 1));
            nv::gemm_f32<<<dim3(D / 128, S / 128), 256, 0, stream>>>(proj, HG_IN, F(b + 2), D, Y, D, D, D);
            nv::res_ln<<<S, 256, 0, stream>>>(hin, Y, F(b + 3), F(b + 4), H);
        } else if (layer == 1) {
            nv::gemm_f32<<<dim3((NSA_IN + 127) / 128, S / 128), 256, 0, stream>>>(hin, D, F(8), NSA_IN, proj, NSA_IN, NSA_IN, D);
            nv::nsa_rot<<<(S * 28 * 16 + 255) / 256, 256, 0, stream>>>(proj, tn);
            nv::nsa_cmp<<<dim3(511, 4, 2), 256, 0, stream>>>(proj, F(9), F(10), F(11), F(12), F(13), F(14), cb);
            nv::nsa_attn<<<dim3(S, 4), 256, 0, stream>>>(proj, cb);
            nv::gemm_f32<<<dim3(D / 128, S / 128), 256, 0, stream>>>(proj, NSA_IN, F(15), D, Y, D, D, D);
            nv::res_ln<<<S, 256, 0, stream>>>(hin, Y, F(16), F(17), H);
        } else {
            nv::gemm_f32<<<dim3(SWA_IN / 128, S / 128), 256, 0, stream>>>(hin, D, F(18), SWA_IN, proj, SWA_IN, SWA_IN, D);
            nv::swa_rot<<<(S * 36 * 8 + 255) / 256, 256, 0, stream>>>(proj, tw);
            nv::swa_attn<<<dim3(S, 32), 64, 0, stream>>>(proj, F(19));
            nv::gemm_f32<<<dim3(D / 128, S / 128), 256, 0, stream>>>(proj, SWA_IN, F(20), D, Y, D, D, D);
            nv::res_ln<<<S, 256, 0, stream>>>(hin, Y, F(21), F(22), H);
        }
        hin = H;
    }
}
#endif
#ifndef ONLY
#define ONLY -1
#endif
#define PHON(n) (ONLY < 0 || ONLY == (n))
#ifdef DIAG_TS
#define TS_MARK() do { if (blockIdx.x == 0 && threadIdx.x == 0) ((unsigned long long*)((unsigned*)(A.ws + WS_CTL) + 16384 + 64))[tsk] = __builtin_amdgcn_s_memrealtime(); ++tsk; } while (0)
#else
#define TS_MARK() do { (void)tsk; } while (0)
#endif
template <int layer> __device__ __forceinline__ void run_layer(const Ctx& C, const Args& A, const XcdBarrier& bar) {
    const int bx = blockIdx.x, G = C.G; unsigned char* ws = A.ws; float* H = A.out;
    int tsk = 1 + (layer == 0 ? 0 : layer == 1 ? 6 : layer == 2 ? 11 : 15);
    bf16* HB = (bf16*)(ws + WS_HB); bf16* WIN = (bf16*)(ws + WS_WIN); bf16* WOUT = (bf16*)(ws + WS_WOUT);
#define GRID_BAR() do { xcd_barrier(bar); TS_MARK(); } while (0)

        constexpr int kind = layer == 3 ? 0 : layer;
        const float* hprev = layer == 0 ? (const float*)A.in[0] : H;
        constexpr int pb = layer == 0 ? 3 : layer == 1 ? 8 : layer == 2 ? 18 : 23;
        if (!(PHON(1) || ONLY >= 10)) {} else if (kind == 0 && (ONLY < 10 || ONLY == 10)) {
            pg8::Gemm g{HB, WIN, S, 8192, DM}; pg8::StaticOrder So; So.init(S, 8192, G, bx);
            pg8::EpiHG E{ws, layer == 0 ? nullptr : (const float*)(ws + WS_LB)};
            pg8::gemm_phase<pg8::EpiHG, pg8::StaticOrder, true, true>(C.lds, g, So, E);
        } else if (kind == 1 && (ONLY < 10 || ONLY == 11)) {
            pg8::Gemm g{HB, WIN, S, 7424, DM}; pg8::StaticOrder So; So.init(S, 7424, G, bx);
            pg8::EpiNSA E{ws};
            pg8::gemm_phase<pg8::EpiNSA, pg8::StaticOrder, true, true>(C.lds, g, So, E);
        } else if (kind == 2 && (ONLY < 10 || ONLY == 12)) {
            pg8::Gemm g{HB, WIN, S, 4608, DM}; pg8::StaticOrder So; So.init(S, 4608, G, bx);
            pg8::EpiSWA E{ws};
            pg8::gemm_phase<pg8::EpiSWA, pg8::StaticOrder, true, true>(C.lds, g, So, E);
        }
        GRID_BAR();
        if (kind == 0) {
            if (PHON(2)) for (int u = bx; u < 2048; u += G) hgx_unit(C, ws, u >> 4, u & 15);
            GRID_BAR();
            if (PHON(3)) hgy_phase(C, ws);
            GRID_BAR();
            if (PHON(3)) for (int u = bx; u < 2048; u += G) hgz_unit(C, ws, u >> 4, u & 15, (const float*)A.in[pb + 1]);
            GRID_BAR();
        } else if (kind == 1) {
            if (PHON(4)) for (int u = bx; u < 256; u += G) nsa_cmp_unit(C, ws, u);
            GRID_BAR();
            if (PHON(5)) for (int k = bx; k < 512; k += G) { const int pi = k & 255, second = k >> 8, g = pi & 3, b = pi >> 2; nsa_attn_unit(C, ws, second ? b : 127 - b, g); }
            GRID_BAR();
        } else {
            if (PHON(6)) for (int u = bx; u < 1024; u += G) { swa_attn_unit(C, ws, u >> 2, u & 3, (const float*)A.in[19]); __syncthreads(); }
            GRID_BAR();
        }
        if (PHON(7)) {
            const int wo = kind == 0 ? pb + 2 : kind == 1 ? 15 : 20; (void)wo;
            pg8::Gemm g{HB, WOUT, S, DM, DM}; pg8::StaticOrder So; So.init(S, DM, G, bx);
            pg8::EpiOut E{hprev, H};
            pg8::gemm_phase<pg8::EpiOut, pg8::StaticOrder, true, true>(C.lds, g, So, E);
        }
        GRID_BAR();
        {
            const int lg = kind == 0 ? pb + 3 : kind == 1 ? 16 : 21;
            if (PHON(8)) ln_phase(C, H, HB, (const float*)A.in[lg], (const float*)A.in[lg + 1], layer < MK_HI);
            if (layer < MK_HI) { if (PHON(9)) conv_layer(C, A, layer + 1); GRID_BAR(); }
        }

#undef GRID_BAR
}
__global__ void __launch_bounds__(NWAVES * 64, 2) mk_fwd(Args A) {
    extern __shared__ __attribute__((aligned(16))) unsigned char lds_raw[];
    Ctx C; C.lds = (LAS unsigned char*)lds_raw; C.tid = threadIdx.x; C.lane = C.tid & 63; C.wave = __builtin_amdgcn_readfirstlane(C.tid >> 6);
    C.G = gridDim.x; { const int bx = blockIdx.x; C.vcu = (C.G % 8 == 0) ? (bx % 8) * (C.G / 8) + bx / 8 : bx; }
    const int bx = blockIdx.x, G = C.G;
    unsigned char* ws = A.ws;
    gu32* ctl = (gu32*)(ws + WS_CTL);
    for (int u = C.tid; u < (LDS_BYTES - LDSCTL_OFF) / 4; u += NWAVES * 64) ((LAS unsigned*)(C.lds + LDSCTL_OFF))[u] = 0u;
    __syncthreads();
    const XcdBarrier bar = xcd_barrier_post((unsigned*)(ctl + CW_BAR), (volatile LAS unsigned*)(C.lds + MISC_OFF) + 8);
#define GRID_BAR() do { xcd_barrier(bar); TS_MARK(); } while (0)

    int tsk = 0; TS_MARK();
    if (PHON(0)) { conv_layer(C, A, MK_LO); p0_misc(C, A); }
    GRID_BAR();

    if (MK_LO <= 0 && 0 <= MK_HI) run_layer<0>(C, A, bar);
    if (MK_LO <= 1 && 1 <= MK_HI) run_layer<1>(C, A, bar);
    if (MK_LO <= 2 && 2 <= MK_HI) run_layer<2>(C, A, bar);
    if (MK_LO <= 3 && 3 <= MK_HI) run_layer<3>(C, A, bar);
    tsk = 22; TS_MARK();
#undef GRID_BAR
}

#ifdef DIAG_TS
__global__ void ts_encode(const unsigned* c, float* out) { const unsigned long long* ts = (const unsigned long long*)(c + 64);
    const float ua = (float)(ts[DIAG_A + 1] - ts[DIAG_A]) * 0.01f; const float d = sqrtf(ua * 1e-6f);
    const size_t i = (size_t)blockIdx.x * blockDim.x + threadIdx.x; out[i] += d; }
#endif
#ifdef DBG_NAN
__global__ void dbg_encode(const unsigned* cnt, float* out) { unsigned code = 1u + (cnt[0] ? 1u : 0u) + (cnt[1] ? 2u : 0u) + (cnt[2] ? 4u : 0u); out[0] += sqrtf((float)code) * 12961.f; }
#endif
extern "C" void kernel_launch(void* const* d_in, const int* in_sizes, int n_in, void* d_out, int out_size, void* d_ws, size_t ws_size, hipStream_t stream) {
    static int grid = 0;
    if (grid == 0) {
        if (n_in != 28 || out_size != S * DM || ws_size < WS_END) { fprintf(stderr, "kernel_launch: unexpected n_in %d / out_size %d / ws_size %zu (need %zu)\n", n_in, out_size, ws_size, (size_t)WS_END); grid = -1; return; }
        int dev = 0, cus = 0, per_cu = 0;
        if (hipGetDevice(&dev) != hipSuccess || hipDeviceGetAttribute(&cus, hipDeviceAttributeMultiprocessorCount, dev) != hipSuccess) { grid = -1; return; }
        if (hipFuncSetAttribute((const void*)mk_fwd, hipFuncAttributeMaxDynamicSharedMemorySize, LDS_BYTES) != hipSuccess) { fprintf(stderr, "kernel_launch: hipFuncSetAttribute failed\n"); grid = -1; return; }
        if (hipOccupancyMaxActiveBlocksPerMultiprocessor(&per_cu, (const void*)mk_fwd, NWAVES * 64, LDS_BYTES) != hipSuccess || per_cu < 1) { fprintf(stderr, "kernel_launch: occupancy query reports %d blocks per CU\n", per_cu); per_cu = 1; }
        (void)hipGetLastError();
        grid = cus;
    }
    if (grid < 0) return;
    RotC rc0{};
    for (int i = 0; i < 16; ++i) rc0.nsa[i] = std::pow(500000.0, -(double)(2 * i) / 32.0) / 6.283185307179586;
    for (int i = 0; i < 8; ++i) rc0.swa[i] = std::pow(500000.0, -(double)(2 * i) / 16.0) / 6.283185307179586;
#ifdef HYBRID
    naive_layers(0, MK_LO - 1, d_in, (float*)d_out, (char*)d_ws, stream, rc0);
#endif
    (void)hipMemsetAsync((char*)d_ws + WS_CTL, 0, CTL_ZERO_BYTES, stream);
    Args a{};
    for (int i = 0; i < 28; ++i) a.in[i] = d_in[i];
    a.out = (float*)d_out; a.ws = (unsigned char*)d_ws;
    for (int i = 0; i < 16; ++i) a.rc.nsa[i] = std::pow(500000.0, -(double)(2 * i) / 32.0) / 6.283185307179586;
    for (int i = 0; i < 8; ++i) a.rc.swa[i] = std::pow(500000.0, -(double)(2 * i) / 16.0) / 6.283185307179586;
    void* kargs[] = {&a};
    hipError_t e = hipLaunchCooperativeKernel((const void*)mk_fwd, dim3(grid), dim3(NWAVES * 64), kargs, LDS_BYTES, stream);
    if (e != hipSuccess) { (void)hipGetLastError(); fprintf(stderr, "kernel_launch: cooperative launch failed (%s); plain launch of the same resident grid\n", hipGetErrorString(e));
        hipLaunchKernelGGL(mk_fwd, dim3(grid), dim3(NWAVES * 64), LDS_BYTES, stream, a); }
#ifdef DIAG_TS
    ts_encode<<<S * DM / 256, 256, 0, stream>>>((const unsigned*)((char*)d_ws + WS_CTL) + 16384, (float*)d_out);
#endif
#ifdef DBG_NAN
    dbg_encode<<<1, 1, 0, stream>>>((const unsigned*)((char*)d_ws + WS_CTL) + 8192, (float*)d_out);
#endif
#ifdef HYBRID
    naive_layers(MK_HI + 1, 3, d_in, (float*)d_out, (char*)d_ws, stream, rc0);
#endif
}
```
